# Optimizing an MI355X kernel written in HIP

```python
import math
import jax, jax.numpy as jnp
from jax import lax
import numpy as np

D_MODEL = 1024
BATCH = 16
SEQ = 2048
DEPTH = 2

MIX_WIDTH = D_MODEL
HEAD_DIM = 64
NSA_HEADS = 8
NSA_KV_GROUPS = 2
HEADS_PER_GROUP = NSA_HEADS // NSA_KV_GROUPS
NSA_WIDTH = NSA_HEADS * HEAD_DIM
KV_WIDTH = NSA_KV_GROUPS * HEAD_DIM
CONV_WIDTH = MIX_WIDTH - NSA_WIDTH
CONV_GROUPS = CONV_WIDTH // HEAD_DIM
CONV_K = 3
CMP_STRIDE = 16
CMP_BLOCK = 2 * CMP_STRIDE
CMP_HIDDEN = 128
SLC_BLOCK = 64
SLC_TOPK = 8
WINDOW = 256
Q_BLOCK = 64
FORCE_BONUS = 1.0e4
N_BUCKETS = 32
MAX_DISTANCE = 128
MEM_HEADS = 4
MEM_HEAD_DIM = 64
MEM_WIDTH = MEM_HEADS * MEM_HEAD_DIM
MEM_LEN = 256
FFN_HIDDEN = -(-8 * D_MODEL // (3 * 256)) * 256
RMS_EPS = 1e-6
NEG_INF = -1e30
IN_SIZES = (NSA_WIDTH,) + (KV_WIDTH,) * 6 + (3 * NSA_HEADS,) + (CONV_WIDTH,) * 3
IN_WIDTH = sum(IN_SIZES)
IN_SPLITS = tuple(int(s) for s in np.cumsum(IN_SIZES)[:-1])

kernel_name = "hymba_nsa_shortconv_hybrid"


def rmsnorm(x, g):
    xf = x.astype(jnp.float32)
    y = xf * lax.rsqrt(jnp.mean(xf * xf, axis=-1, keepdims=True) + RMS_EPS)
    return (y * g.astype(jnp.float32)).astype(x.dtype)


def t5_bucket(dist):
    n = jnp.maximum(dist, 0)
    max_exact = N_BUCKETS // 2
    nf = jnp.maximum(n, 1).astype(jnp.float32)
    large = max_exact + (jnp.log(nf / max_exact) / math.log(MAX_DISTANCE / max_exact)
                         * (N_BUCKETS - max_exact)).astype(jnp.int32)
    large = jnp.minimum(large, N_BUCKETS - 1)
    return jnp.where(n < max_exact, n, large)


def masked_softmax(logits, mask, axis):
    maskf = mask.astype(jnp.float32)
    logits = jnp.where(mask, logits, NEG_INF)
    m = jnp.max(logits, axis=axis, keepdims=True)
    e = jnp.exp(logits - m) * maskf
    return e / jnp.maximum(jnp.sum(e, axis=axis, keepdims=True), 1e-30)


def compress_blocks(kv, pe, w1, w2):
    B, S, G, Dh = kv.shape
    ch = kv.reshape(B, S // CMP_STRIDE, CMP_STRIDE, G, Dh)
    blocks = jnp.concatenate([ch[:, :-1], ch[:, 1:]], axis=2)
    blocks = blocks + pe[None, None, :, None, :]
    n = blocks.shape[1]
    flat = blocks.transpose(0, 1, 3, 2, 4).reshape(B, n, G, CMP_BLOCK * Dh)
    return jax.nn.gelu(flat @ w1) @ w2


def nsa_attention(q, k_c, v_c, k_s, v_s, k_w, v_w, gates, rel_bias, pe, ck1, ck2, cv1, cv2):
    B, S, G, HPG, Dh = q.shape
    scale = Dh ** -0.5
    kcmp = compress_blocks(k_c, pe, ck1, ck2)
    vcmp = compress_blocks(v_c, pe, cv1, cv2)
    n_cmp = kcmp.shape[1]
    cmp_end = jnp.arange(n_cmp, dtype=jnp.int32) * CMP_STRIDE + CMP_BLOCK - 1
    n_slc = S // SLC_BLOCK
    topk = min(SLC_TOPK, n_slc)
    cs = np.arange(n_cmp) * CMP_STRIDE
    ss = np.arange(n_slc) * SLC_BLOCK
    ov = np.clip(np.minimum(cs[:, None] + CMP_BLOCK, ss[None, :] + SLC_BLOCK)
                 - np.maximum(cs[:, None], ss[None, :]), 0, None) / CMP_BLOCK
    ov = jnp.asarray(ov, dtype=jnp.float32)
    ks_blk = k_s.reshape(B, n_slc, SLC_BLOCK, G, Dh).transpose(0, 3, 1, 2, 4)
    vs_blk = v_s.reshape(B, n_slc, SLC_BLOCK, G, Dh).transpose(0, 3, 1, 2, 4)
    gather_blocks = jax.vmap(jax.vmap(lambda kb, ix: kb[ix]))
    rb_sel = rel_bias.reshape(G, HPG, N_BUCKETS).transpose(0, 2, 1)
    g_index = jnp.arange(G)[None, None, :, None, None]
    kw_pad = jnp.pad(k_w, ((0, 0), (WINDOW, 0), (0, 0), (0, 0)))
    vw_pad = jnp.pad(v_w, ((0, 0), (WINDOW, 0), (0, 0), (0, 0)))
    kw_len = WINDOW + Q_BLOCK
    dist_w = jnp.arange(Q_BLOCK)[:, None] + WINDOW - jnp.arange(kw_len)[None, :]
    band = (dist_w >= 0) & (dist_w < WINDOW)
    bias_w = rel_bias[:, t5_bucket(dist_w)].reshape(G, HPG, Q_BLOCK, kw_len).transpose(2, 0, 1, 3)

    def chunk(args):
        c, q_c, g_c = args
        t = c * Q_BLOCK + jnp.arange(Q_BLOCK, dtype=jnp.int32)
        dist_c = t[:, None] - cmp_end[None, :]
        bias_c = rel_bias[:, t5_bucket(dist_c)].reshape(G, HPG, Q_BLOCK, n_cmp).transpose(2, 0, 1, 3)
        lg = jnp.einsum('bqghd,bngd->bqghn', q_c, kcmp).astype(jnp.float32) * scale + bias_c
        p_cmp = masked_softmax(lg, (dist_c >= 0)[:, None, None, :], -1)
        o_cmp = jnp.einsum('bqghn,bngd->bqghd', p_cmp, vcmp.astype(jnp.float32))
        imp = jnp.einsum('bqghn,nj->bqgj', p_cmp, ov)
        blk = jnp.arange(n_slc, dtype=jnp.int32)[None, :]
        cur = (t // SLC_BLOCK)[:, None]
        valid = blk <= cur
        forced = (blk == 0) | (blk == cur) | (blk == cur - 1)
        score = jnp.where(valid[:, None, :], imp + jnp.where(forced, FORCE_BONUS, 0.0)[:, None, :], NEG_INF)
        top_val, top_idx = lax.top_k(score, topk)
        sel_ok = top_val > 0.5 * NEG_INF
        idx_bg = top_idx.transpose(0, 2, 1, 3)
        k_sel = gather_blocks(ks_blk, idx_bg)
        v_sel = gather_blocks(vs_blk, idx_bg)
        pos = top_idx[..., None] * SLC_BLOCK + jnp.arange(SLC_BLOCK, dtype=jnp.int32)
        dist_s = t[None, :, None, None, None] - pos
        mask_s = sel_ok[..., None] & (dist_s >= 0)
        bias_s = jnp.moveaxis(rb_sel[g_index, t5_bucket(dist_s)], -1, 3)
        lg = jnp.einsum('bqghd,bgqkjd->bqghkj', q_c, k_sel).astype(jnp.float32) * scale + bias_s
        p_sel = masked_softmax(lg, mask_s[:, :, :, None], (-2, -1))
        o_sel = jnp.einsum('bqghkj,bgqkjd->bqghd', p_sel, v_sel.astype(jnp.float32))
        kw_c = lax.dynamic_slice_in_dim(kw_pad, c * Q_BLOCK, kw_len, axis=1)
        vw_c = lax.dynamic_slice_in_dim(vw_pad, c * Q_BLOCK, kw_len, axis=1)
        s_pos = c * Q_BLOCK - WINDOW + jnp.arange(kw_len, dtype=jnp.int32)
        mask_w = band & (s_pos >= 0)[None, :]
        lg = jnp.einsum('bqghd,bkgd->bqghk', q_c, kw_c).astype(jnp.float32) * scale + bias_w
        p_win = masked_softmax(lg, mask_w[:, None, None, :], -1)
        o_win = jnp.einsum('bqghk,bkgd->bqghd', p_win, vw_c.astype(jnp.float32))
        out = g_c[..., 0:1] * o_cmp + g_c[..., 1:2] * o_sel + g_c[..., 2:3] * o_win
        return out.astype(q.dtype)

    nc = S // Q_BLOCK
    q_chunks = jnp.moveaxis(q.reshape(B, nc, Q_BLOCK, G, HPG, Dh), 1, 0)
    g_chunks = jnp.moveaxis(gates.reshape(B, nc, Q_BLOCK, G, HPG, 3), 1, 0)
    out = lax.map(chunk, (jnp.arange(nc, dtype=jnp.int32), q_chunks, g_chunks))
    return jnp.moveaxis(out, 0, 1).reshape(B, S, G, HPG, Dh)


def hybrid_mixer(h, w_in, w_out, gn_nsa, gn_conv, conv_w, rel_bias, pe, ck1, ck2, cv1, cv2):
    B, S, _ = h.shape
    proj = h @ w_in
    q, kc, vc, ks, vs, kw, vw, gl, cb, cc, cx = jnp.split(proj, IN_SPLITS, axis=-1)
    G, HPG, Dh = NSA_KV_GROUPS, HEADS_PER_GROUP, HEAD_DIM
    kvr = lambda a: a.reshape(B, S, G, Dh)
    gates = jax.nn.sigmoid(gl.astype(jnp.float32)).reshape(B, S, G, HPG, 3)
    o_nsa = nsa_attention(q.reshape(B, S, G, HPG, Dh), kvr(kc), kvr(vc), kvr(ks), kvr(vs),
                          kvr(kw), kvr(vw), gates, rel_bias, pe, ck1, ck2, cv1, cv2)
    o_nsa = o_nsa.reshape(B, S, NSA_WIDTH)
    u = cc * cx
    u_pad = jnp.pad(u, ((0, 0), (CONV_K - 1, 0), (0, 0)))
    y = sum(conv_w[k] * u_pad[:, CONV_K - 1 - k: CONV_K - 1 - k + S] for k in range(CONV_K))
    o_conv = cb * y
    merged = jnp.concatenate([rmsnorm(o_nsa, gn_nsa), rmsnorm(o_conv, gn_conv)], axis=-1)
    return merged @ w_out


def memory_attention(h, mem_n, wq, wkv, wo):
    B, S, _ = h.shape
    M = mem_n.shape[1]
    q = (h @ wq).reshape(B, S, MEM_HEADS, MEM_HEAD_DIM)
    k, v = jnp.split(mem_n @ wkv, 2, axis=-1)
    k = k.reshape(B, M, MEM_HEADS, MEM_HEAD_DIM)
    v = v.reshape(B, M, MEM_HEADS, MEM_HEAD_DIM)
    lg = jnp.einsum('bshd,bmhd->bhsm', q, k).astype(jnp.float32) * (MEM_HEAD_DIM ** -0.5)
    p = jax.nn.softmax(lg, axis=-1)
    o = jnp.einsum('bhsm,bmhd->bshd', p, v.astype(jnp.float32)).reshape(B, S, MEM_WIDTH)
    return o.astype(h.dtype) @ wo


def swiglu(h, wg, wu, wd):
    return (jax.nn.silu(h @ wg) * (h @ wu)) @ wd


def setup_inputs(seed: int = 0) -> dict:
    key = jax.random.key(seed)
    ks = jax.random.split(key, 24)
    f32 = jnp.float32
    nrm = lambda k, shape, fan_in: jax.random.normal(k, shape, f32) * fan_in ** -0.5
    gain = lambda k, shape: 1.0 + 0.05 * jax.random.normal(k, shape, f32)
    return {
        "x": jax.random.normal(ks[0], (BATCH, SEQ, D_MODEL), f32),
        "mem": jax.random.normal(ks[1], (BATCH, MEM_LEN, D_MODEL), f32),
        "rel_bias": 0.3 * jax.random.normal(ks[2], (NSA_HEADS, N_BUCKETS), f32),
        "norms": gain(ks[3], (DEPTH, 6, D_MODEL)),
        "mem_norm": gain(ks[4], (DEPTH, D_MODEL)),
        "gn_nsa": gain(ks[5], (DEPTH, NSA_WIDTH)),
        "gn_conv": gain(ks[6], (DEPTH, CONV_WIDTH)),
        "w_in": nrm(ks[7], (DEPTH, D_MODEL, IN_WIDTH), D_MODEL),
        "w_out": nrm(ks[8], (DEPTH, MIX_WIDTH, D_MODEL), MIX_WIDTH),
        "cmp_pe": 0.1 * jax.random.normal(ks[9], (DEPTH, CMP_BLOCK, HEAD_DIM), f32),
        "cmp_k_w1": nrm(ks[10], (DEPTH, CMP_BLOCK * HEAD_DIM, CMP_HIDDEN), CMP_BLOCK * HEAD_DIM),
        "cmp_k_w2": nrm(ks[11], (DEPTH, CMP_HIDDEN, HEAD_DIM), CMP_HIDDEN),
        "cmp_v_w1": nrm(ks[12], (DEPTH, CMP_BLOCK * HEAD_DIM, CMP_HIDDEN), CMP_BLOCK * HEAD_DIM),
        "cmp_v_w2": nrm(ks[13], (DEPTH, CMP_HIDDEN, HEAD_DIM), CMP_HIDDEN),
        "conv_w": nrm(ks[14], (DEPTH, CONV_K, CONV_WIDTH), CONV_K),
        "mem_wq": nrm(ks[15], (DEPTH, D_MODEL, MEM_WIDTH), D_MODEL),
        "mem_wkv": nrm(ks[16], (DEPTH, D_MODEL, 2 * MEM_WIDTH), D_MODEL),
        "mem_wo": nrm(ks[17], (DEPTH, MEM_WIDTH, D_MODEL), MEM_WIDTH),
        "ffn_wg": nrm(ks[18], (DEPTH, D_MODEL, FFN_HIDDEN), D_MODEL),
        "ffn_wu": nrm(ks[19], (DEPTH, D_MODEL, FFN_HIDDEN), D_MODEL),
        "ffn_wd": nrm(ks[20], (DEPTH, FFN_HIDDEN, D_MODEL), FFN_HIDDEN),
    }


def reference(x, mem, rel_bias, norms, mem_norm, gn_nsa, gn_conv, w_in, w_out, cmp_pe,
              cmp_k_w1, cmp_k_w2, cmp_v_w1, cmp_v_w2, conv_w, mem_wq, mem_wkv, mem_wo,
              ffn_wg, ffn_wu, ffn_wd):
    for l in range(DEPTH):
        h = hybrid_mixer(rmsnorm(x, norms[l, 0]), w_in[l], w_out[l], gn_nsa[l], gn_conv[l], conv_w[l],
                         rel_bias, cmp_pe[l], cmp_k_w1[l], cmp_k_w2[l], cmp_v_w1[l], cmp_v_w2[l])
        x = x + rmsnorm(h, norms[l, 1])
        h = memory_attention(rmsnorm(x, norms[l, 2]), rmsnorm(mem, mem_norm[l]),
                             mem_wq[l], mem_wkv[l], mem_wo[l])
        x = x + rmsnorm(h, norms[l, 3])
        h = swiglu(rmsnorm(x, norms[l, 4]), ffn_wg[l], ffn_wu[l], ffn_wd[l])
        x = x + rmsnorm(h, norms[l, 5])
    return x
```

```cpp
#include <hip/hip_runtime.h>
#include <hip/hip_cooperative_groups.h>
#include <cstdio>
#include <cstdint>
namespace cg = cooperative_groups;
namespace pg8 {
#define PG8_LAS __attribute__((address_space(3)))
typedef unsigned short bf16_t;
typedef short bf16x8 __attribute__((ext_vector_type(8)));
typedef float f32x4 __attribute__((ext_vector_type(4)));
typedef unsigned u32x4 __attribute__((ext_vector_type(4)));
constexpr int BM = 256, BK = 64, HALF = 128, HTB = HALF * BK * 2  , STAGE_BYTES = 8 * HTB, NXCD = 8, WGM = 8;

__host__ __device__ __forceinline__ int lds_byte(int r, int c) { const int st = (r >> 4) * 2 + (c >> 5), rr = r & 15, cc = c & 31, ob = rr * 64 + cc * 2; return st * 1024 + (ob ^ (((ob >> 9) & 1) << 5)); }
__host__ __device__ __forceinline__ void stage_rc(int b, int& R, int& C) { const int st = b / 1024, sb = b % 1024, swz = sb ^ (((sb >> 9) & 1) << 5); R = (st >> 1) * 16 + swz / 64; C = (st & 1) * 32 + (swz % 64) / 2; }
__host__ __device__ __forceinline__ int perm32(int rho) { const int n = rho >> 4, i = rho & 15; return 8 * (i >> 2) + 4 * n + (i & 3); }

struct Unit { int pm, pn; };
struct Gemm { const bf16_t* A; const bf16_t* Bt; int M, N, K; };

struct StaticOrder {
    int nM, nN, nwg, G, c;
    __host__ __device__ void init(int M, int N, int G_, int c_) { nM = M / BM; nN = N / BM; nwg = nM * nN; G = G_; c = c_; }
    __host__ __device__ bool next(int i, Unit& u) const {
        const long L = (long)i * G + c; if (L >= nwg) return false;
        int wgid = (int)L; { const int q = nwg / NXCD, r = nwg % NXCD, xcd = wgid % NXCD, off = wgid / NXCD; wgid = (xcd < r ? xcd * (q + 1) : r * (q + 1) + (xcd - r) * q) + off; }
        const int nig = WGM * nN, gid = wgid / nig, fm = gid * WGM, gsz = (nM - fm) < WGM ? (nM - fm) : WGM;
        u.pm = fm + ((wgid % nig) % gsz); u.pn = (wgid % nig) / gsz; return true;
    }
    __device__ __forceinline__ void a_ready(const Unit&) const {}
    __device__ __forceinline__ void done(const Unit&) const {}
};

__device__ __forceinline__ unsigned cvt_pk_bf16(float lo, float hi) { unsigned r; asm volatile("v_cvt_pk_bf16_f32 %0, %1, %2" : "=v"(r) : "v"(lo), "v"(hi)); return r; }
typedef float f32x2 __attribute__((ext_vector_type(2)));
struct EpiStoreBf16 {
    static constexpr bool PERM = true, AFTER_DRAIN = false;
    bf16_t* O; int ldc;
    __device__ __forceinline__ void operator()(const f32x4 (&acc)[2][2][4][2], const Unit& u, int wr, int wc, int fr, int fq) const {
        const int row0 = u.pm * BM + wr * 64 + fr, col0 = u.pn * BM + wc * 32 + 8 * fq;
#pragma unroll
        for (int ai = 0; ai < 2; ++ai)
#pragma unroll
            for (int m = 0; m < 4; ++m) { bf16_t* rowp = O + (size_t)(row0 + ai * HALF + m * 16) * ldc + col0;
#pragma unroll
                for (int bj = 0; bj < 2; ++bj) { const f32x4 v0 = acc[ai][bj][m][0], v1 = acc[ai][bj][m][1];
                    u32x4 w; w.x = cvt_pk_bf16(v0[0], v0[1]); w.y = cvt_pk_bf16(v0[2], v0[3]); w.z = cvt_pk_bf16(v1[0], v1[1]); w.w = cvt_pk_bf16(v1[2], v1[3]);
                    *(u32x4*)(rowp + bj * HALF) = w; } }
    }
};
struct EpiStoreF32 {
    static constexpr bool PERM = true, AFTER_DRAIN = false;
    float* O; int ldc;
    __device__ __forceinline__ void operator()(const f32x4 (&acc)[2][2][4][2], const Unit& u, int wr, int wc, int fr, int fq) const {
        const int row0 = u.pm * BM + wr * 64 + fr, col0 = u.pn * BM + wc * 32 + 8 * fq;
#pragma unroll
        for (int ai = 0; ai < 2; ++ai)
#pragma unroll
            for (int m = 0; m < 4; ++m) { float* rowp = O + (size_t)(row0 + ai * HALF + m * 16) * ldc + col0;
#pragma unroll
                for (int bj = 0; bj < 2; ++bj) { *(f32x4*)(rowp + bj * HALF) = acc[ai][bj][m][0]; *(f32x4*)(rowp + bj * HALF + 4) = acc[ai][bj][m][1]; } }
    }
};
struct EpiSwiGLU {
    static constexpr bool PERM = true, AFTER_DRAIN = false;
    bf16_t* O; int ldc;
    __device__ __forceinline__ void operator()(const f32x4 (&acc)[2][2][4][2], const Unit& u, int wr, int wc, int fr, int fq) const {
        const int row0 = u.pm * BM + wr * 64 + fr, col0 = u.pn * HALF + wc * 32 + 8 * fq;
#pragma unroll
        for (int ai = 0; ai < 2; ++ai)
#pragma unroll
            for (int m = 0; m < 4; ++m) { bf16_t* rowp = O + (size_t)(row0 + ai * HALF + m * 16) * ldc + col0;
                float h[8];
#pragma unroll
                for (int n = 0; n < 2; ++n)
#pragma unroll
                    for (int i = 0; i < 4; ++i) { const float g = acc[ai][0][m][n][i], up = acc[ai][1][m][n][i]; h[4 * n + i] = g * up / (1.0f + __expf(-g)); }
                u32x4 w; w.x = cvt_pk_bf16(h[0], h[1]); w.y = cvt_pk_bf16(h[2], h[3]); w.z = cvt_pk_bf16(h[4], h[5]); w.w = cvt_pk_bf16(h[6], h[7]);
                *(u32x4*)rowp = w; }
    }
};
template <class Epi, class Sched, bool ALIGN_EPI = false, bool SP2 = false>
__device__ __forceinline__ void gemm_phase(PG8_LAS unsigned char* lds, const Gemm g, const Sched& S, const Epi& E) {
    int tid_raw = __builtin_amdgcn_mbcnt_hi(~0u, __builtin_amdgcn_mbcnt_lo(~0u, 0u)); asm volatile("" : "+v"(tid_raw)); tid_raw += 64 * __builtin_amdgcn_readfirstlane((int)(threadIdx.x >> 6));
    const int tid = tid_raw, wid = __builtin_amdgcn_readfirstlane(tid >> 6), lane = tid & 63, wr = wid >> 2, wc = wid & 3, fr = lane & 15, fq = lane >> 4;
    const int K = g.K, nt = K / BK;
    unsigned voffA[2], voffB[2];
#pragma unroll
    for (int i = 0; i < 2; ++i) { int R, C; stage_rc(tid * 16 + i * 8192, R, C); const int Rb = Epi::PERM ? ((R & ~31) + perm32(R & 31)) : R;
        voffA[i] = (unsigned)(R * K + C) * 2u; voffB[i] = (unsigned)(Rb * K + C) * 2u; }
    const size_t kstep = (size_t)(BK * 2);
    const size_t hstep = (size_t)HALF * K * 2;
    const size_t tstep = 2 * hstep;
    const unsigned ldsw = (unsigned)wid * 1024u;
    const int aoff = lds_byte(wr * 64 + fr, fq * 8), boff = lds_byte(wc * 32 + fr, fq * 8);
#define PG8_SA(b, h) (((b) * 2 + (h)) * HTB)
#define PG8_SB(b, h) ((4 + (b) * 2 + (h)) * HTB)
#define PG8_STAGE(bufoff, gbase, voff) do { _Pragma("unroll") for (int _i = 0; _i < 2; ++_i) \
        __builtin_amdgcn_global_load_lds((const unsigned*)((const char*)(gbase) + (voff)[_i]), (PG8_LAS unsigned*)(lds + (bufoff) + ldsw + _i * 8192), 16, 0, 0); } while (0)
#define PG8_LDA(dst, b, h) do { _Pragma("unroll") for (int m = 0; m < 4; ++m) _Pragma("unroll") for (int k = 0; k < 2; ++k) dst[m][k] = *(const PG8_LAS bf16x8*)(lds + PG8_SA(b, h) + aoff + m * 2048 + k * 1024); } while (0)
#define PG8_LDB(dst, b, h) do { _Pragma("unroll") for (int n = 0; n < 2; ++n) _Pragma("unroll") for (int k = 0; k < 2; ++k) dst[n][k] = *(const PG8_LAS bf16x8*)(lds + PG8_SB(b, h) + boff + n * 2048 + k * 1024); } while (0)
#define PG8_MMA(ai, bj, At, Bt) do { __builtin_amdgcn_s_setprio(1); _Pragma("unroll") for (int m = 0; m < 4; ++m) _Pragma("unroll") for (int n = 0; n < 2; ++n) _Pragma("unroll") for (int k = 0; k < 2; ++k) \
        acc[ai][bj][m][n] = __builtin_amdgcn_mfma_f32_16x16x32_bf16(Bt[n][k], At[m][k], acc[ai][bj][m][n], 0, 0, 0); __builtin_amdgcn_s_setprio(0); } while (0)
#define PG8_WAIT_V(n) asm volatile("s_waitcnt vmcnt(" #n ")" ::: "memory")
#define PG8_WAIT_L(n) asm volatile("s_waitcnt lgkmcnt(" #n ")" ::: "memory")
#define PG8_BAR __builtin_amdgcn_s_barrier()
#define PG8_SCHED __builtin_amdgcn_sched_barrier(0)
    Unit cur, nxt; int ui = 0;
    if (!S.next(0, cur)) return;
    f32x4 acc[2][2][4][2];
#pragma unroll
    for (int a = 0; a < 2; ++a)
#pragma unroll
        for (int b = 0; b < 2; ++b)
#pragma unroll
            for (int m = 0; m < 4; ++m)
#pragma unroll
                for (int n = 0; n < 2; ++n) acc[a][b][m][n] = (f32x4){0.f, 0.f, 0.f, 0.f};
    bf16x8 At[4][2], B0[2][2], B1[2][2];
    const char* cA = (const char*)g.A + (size_t)cur.pm * tstep; const char* cB = (const char*)g.Bt + (size_t)cur.pn * tstep;
    S.a_ready(cur);
    if constexpr (SP2) {
        PG8_STAGE(PG8_SB(0, 0), cB, voffB); PG8_STAGE(PG8_SB(0, 1), cB + hstep, voffB); PG8_STAGE(PG8_SA(0, 0), cA, voffA); PG8_STAGE(PG8_SA(0, 1), cA + hstep, voffA);
        if (wr == 1) PG8_BAR;
        PG8_WAIT_V(2); PG8_BAR;
        PG8_STAGE(PG8_SB(1, 0), cB + kstep, voffB); PG8_STAGE(PG8_SA(1, 0), cA + kstep, voffA); PG8_STAGE(PG8_SB(1, 1), cB + hstep + kstep, voffB);
        PG8_WAIT_V(6); PG8_BAR;
    } else {
        PG8_STAGE(PG8_SB(0, 0), cB, voffB); PG8_STAGE(PG8_SA(0, 0), cA, voffA); PG8_STAGE(PG8_SB(0, 1), cB + hstep, voffB); PG8_STAGE(PG8_SA(0, 1), cA + hstep, voffA);
        if (wr == 1) PG8_BAR;
        PG8_WAIT_V(4); PG8_BAR;
        PG8_STAGE(PG8_SB(1, 0), cB + kstep, voffB); PG8_STAGE(PG8_SA(1, 0), cA + kstep, voffA); PG8_STAGE(PG8_SB(1, 1), cB + hstep + kstep, voffB);
        PG8_WAIT_V(6); PG8_BAR;
    }
    for (;;) {
        const bool has_next = S.next(ui + 1, nxt);
        const char* nA = has_next ? (const char*)g.A + (size_t)nxt.pm * tstep : cA; const char* nB = has_next ? (const char*)g.Bt + (size_t)nxt.pn * tstep : cB;
        for (int t = 0; t < nt; t += 2) {
            const bool last = (t == nt - 2);
            const char* a1 = cA + (size_t)(t + 1) * kstep;
            const char* a2 = last ? nA : cA + (size_t)(t + 2) * kstep; const char* b2 = last ? nB : cB + (size_t)(t + 2) * kstep;
            const char* a3 = a2 + kstep; const char* b3 = b2 + kstep;
            if (last && has_next) S.a_ready(nxt);
            if constexpr (SP2) {
            PG8_LDB(B0, 0, 0); PG8_LDB(B1, 0, 1); PG8_SCHED; PG8_LDA(At, 0, 0); PG8_STAGE(PG8_SA(1, 1), a1 + hstep, voffA);
            PG8_WAIT_V(8); PG8_WAIT_L(0); PG8_BAR; PG8_MMA(0, 0, At, B0); PG8_MMA(0, 1, At, B1); PG8_BAR; PG8_SCHED;
            PG8_LDA(At, 0, 1); PG8_STAGE(PG8_SB(0, 0), b2, voffB); PG8_STAGE(PG8_SB(0, 1), b2 + hstep, voffB); PG8_STAGE(PG8_SA(0, 0), a2, voffA);
            PG8_WAIT_V(8); PG8_WAIT_L(0); PG8_BAR; PG8_MMA(1, 0, At, B0); PG8_MMA(1, 1, At, B1); PG8_BAR; PG8_SCHED;
            PG8_LDB(B0, 1, 0); PG8_LDB(B1, 1, 1); PG8_SCHED; PG8_LDA(At, 1, 0); PG8_STAGE(PG8_SA(0, 1), a2 + hstep, voffA);
            PG8_WAIT_V(8); PG8_WAIT_L(0); PG8_BAR; PG8_MMA(0, 0, At, B0); PG8_MMA(0, 1, At, B1); PG8_BAR; PG8_SCHED;
            PG8_LDA(At, 1, 1); PG8_STAGE(PG8_SB(1, 0), b3, voffB); PG8_STAGE(PG8_SB(1, 1), b3 + hstep, voffB); PG8_STAGE(PG8_SA(1, 0), a3, voffA);
            PG8_WAIT_V(8); PG8_WAIT_L(0); PG8_BAR; PG8_MMA(1, 0, At, B0); PG8_MMA(1, 1, At, B1); PG8_BAR; PG8_SCHED;
            } else {
            PG8_LDB(B0, 0, 0); PG8_SCHED; PG8_LDA(At, 0, 0); PG8_STAGE(PG8_SA(1, 1), a1 + hstep, voffA);
            PG8_WAIT_L(8); PG8_BAR; PG8_WAIT_L(0); PG8_MMA(0, 0, At, B0); PG8_BAR; PG8_SCHED;
            PG8_LDB(B1, 0, 1); PG8_STAGE(PG8_SB(0, 0), b2, voffB);
            PG8_BAR; PG8_WAIT_L(0); PG8_MMA(0, 1, At, B1); PG8_BAR;
            PG8_LDA(At, 0, 1); PG8_STAGE(PG8_SA(0, 0), a2, voffA);
            PG8_BAR; PG8_WAIT_L(0); PG8_MMA(1, 0, At, B0); PG8_BAR; PG8_SCHED;
            PG8_STAGE(PG8_SB(0, 1), b2 + hstep, voffB);
            PG8_WAIT_V(6); PG8_BAR; PG8_MMA(1, 1, At, B1); PG8_BAR;
            PG8_LDB(B0, 1, 0); PG8_SCHED; PG8_LDA(At, 1, 0); PG8_STAGE(PG8_SA(0, 1), a2 + hstep, voffA);
            PG8_WAIT_L(8); PG8_BAR; PG8_WAIT_L(0); PG8_MMA(0, 0, At, B0); PG8_BAR; PG8_SCHED;
            PG8_LDB(B1, 1, 1); PG8_STAGE(PG8_SB(1, 0), b3, voffB);
            PG8_BAR; PG8_WAIT_L(0); PG8_MMA(0, 1, At, B1); PG8_BAR;
            PG8_LDA(At, 1, 1); PG8_STAGE(PG8_SA(1, 0), a3, voffA);
            PG8_BAR; PG8_WAIT_L(0); PG8_MMA(1, 0, At, B0); PG8_BAR; PG8_SCHED;
            PG8_STAGE(PG8_SB(1, 1), b3 + hstep, voffB);
            PG8_WAIT_V(6); PG8_BAR; PG8_MMA(1, 1, At, B1); PG8_BAR;
            }
        }
        if constexpr (ALIGN_EPI) { if (wr == 0) PG8_BAR; }
        if constexpr (!Epi::AFTER_DRAIN) { E(acc, cur, wr, wc, fr, fq); S.done(cur); }
        if (!has_next) break;
#pragma unroll
        for (int a = 0; a < 2; ++a)
#pragma unroll
            for (int b = 0; b < 2; ++b)
#pragma unroll
                for (int m = 0; m < 4; ++m)
#pragma unroll
                    for (int n = 0; n < 2; ++n) acc[a][b][m][n] = (f32x4){0.f, 0.f, 0.f, 0.f};
        cur = nxt; cA = nA; cB = nB; ++ui;
        if constexpr (ALIGN_EPI) { if (wr == 1) PG8_BAR; }
    }
    PG8_WAIT_V(0);
    if constexpr (!ALIGN_EPI) { if (wr == 0) PG8_BAR; }
    PG8_BAR;
    if constexpr (Epi::AFTER_DRAIN) { E.fused(acc, cur, wr, wc, fr, fq, lds, wid, lane); S.done(cur); }
#undef PG8_SA
#undef PG8_SB
#undef PG8_STAGE
#undef PG8_LDA
#undef PG8_LDB
#undef PG8_MMA
#undef PG8_WAIT_V
#undef PG8_WAIT_L
#undef PG8_BAR
#undef PG8_SCHED
}
}
#define LAS __attribute__((address_space(3)))
typedef unsigned short bf16;
typedef unsigned u32x4 __attribute__((ext_vector_type(4)));
typedef float f32x4 __attribute__((ext_vector_type(4)));
constexpr int BATCH = 16, SEQ = 2048, DM = 1024, T = BATCH * SEQ, DEPTH = 2;
constexpr int IN_W = 2840, PROJ_LD = 3072, FFN = 2816, MEML = 256;
constexpr int CQ = 0, CKC = 512, CVC = 640, CKS = 768, CVS = 896, CKW = 1024, CVW = 1152, CCB = 1280, CCC = 1792, CCX = 2304, CGL = 2816;
constexpr float RMS_EPS = 1e-6f;
constexpr int NWAVES = 8, NTHREADS = 512;
constexpr int LDS_BYTES = 147456;
constexpr size_t MiB = 1u << 20;
constexpr size_t WS_W = 1 * MiB, W_LAYER = 27 * MiB;
constexpr size_t WO_IN = 0, WO_OUT = 6 * MiB, WO_Q = 8 * MiB, WO_KV = 8 * MiB + 512 * 1024, WO_O = 9 * MiB + 512 * 1024, WO_GU = 10 * MiB, WO_D = 21 * MiB;
constexpr size_t WS_MEMN = 56 * MiB, WS_MEMKV = 72 * MiB, WS_KCMP = 80 * MiB, WS_VCMP = 81 * MiB, WS_QM = 82 * MiB, WS_OM = 98 * MiB, WS_XB = 114 * MiB, WS_H = 178 * MiB, WS_PROJ = 306 * MiB, WS_END = 498 * MiB;

__device__ const int T5_BUCKET[128] = {0,1,2,3,4,5,6,7,8,9,10,11,12,13,14,15,16,16,16,17,17,18,18,18,19,19,19,20,20,20,20,21,21,21,21,22,22,22,22,22,23,23,23,23,23,23,24,24,24,24,24,24,25,25,25,25,25,25,25,26,26,26,26,26,26,26,26,27,27,27,27,27,27,27,27,27,27,28,28,28,28,28,28,28,28,28,28,29,29,29,29,29,29,29,29,29,29,29,29,30,30,30,30,30,30,30,30,30,30,30,30,30,30,31,31,31,31,31,31,31,31,31,31,31,31,31,31,31};

struct Params {
    const float *x, *mem, *rel_bias, *norms, *mem_norm, *gn_nsa, *gn_conv, *w_in, *w_out, *cmp_pe, *ck1, *ck2, *cv1, *cv2, *conv_w, *mem_wq, *mem_wkv, *mem_wo, *ffn_wg, *ffn_wu, *ffn_wd;
    float* out; unsigned char* ws; int ph_lo, ph_hi;
};

__device__ __forceinline__ unsigned f2bf(float f) { unsigned u = __builtin_bit_cast(unsigned, f); return (u + 0x7fffu + ((u >> 16) & 1u)) >> 16; }
__device__ __forceinline__ unsigned pk2(float lo, float hi) { return f2bf(lo) | (f2bf(hi) << 16); }
__device__ __forceinline__ float bflo(unsigned u) { return __uint_as_float(u << 16); }
__device__ __forceinline__ float bfhi(unsigned u) { return __uint_as_float(u & 0xffff0000u); }
__device__ __forceinline__ float wave_sum(float v) {
#pragma unroll
    for (int o = 1; o < 64; o <<= 1) v += __shfl_xor(v, o);
    return v;
}
#define LDS_WAIT() asm volatile("s_waitcnt lgkmcnt(0)" ::: "memory")
__device__ __forceinline__ int opaque_tid() { int t = __builtin_amdgcn_mbcnt_hi(~0u, __builtin_amdgcn_mbcnt_lo(~0u, 0u)); asm volatile("" : "+v"(t)); return t + 64 * __builtin_amdgcn_readfirstlane((int)(threadIdx.x >> 6)); }

__device__ __forceinline__ void transpose_item(const float* W, int N, bf16* WT, int ldk, int k0, int nsrc, int ndst, int nvalid, LAS float* scr, int lane) {
    const int n_ = lane & 31;
#pragma unroll 8
    for (int i = 0; i < 32; ++i) { const int kk = 2 * i + (lane >> 5); scr[kk * 33 + n_] = (n_ < nvalid) ? W[(size_t)(k0 + kk) * N + nsrc + n_] : 0.f; }
    LDS_WAIT(); asm volatile("" ::: "memory");
    const int c = lane & 7;
#pragma unroll
    for (int j = 0; j < 4; ++j) { const int n = (lane >> 3) + 8 * j; const LAS float* s = scr + (8 * c) * 33 + n;
        u32x4 o; o.x = pk2(s[0 * 33], s[1 * 33]); o.y = pk2(s[2 * 33], s[3 * 33]); o.z = pk2(s[4 * 33], s[5 * 33]); o.w = pk2(s[6 * 33], s[7 * 33]);
        *(u32x4*)(WT + (size_t)(ndst + n) * ldk + k0 + 8 * c) = o; }
    LDS_WAIT(); asm volatile("" ::: "memory");
}
__device__ __forceinline__ void weights_phase(const Params& p, LAS unsigned char* lds) {
    const int tid = opaque_tid(), lane = tid & 63, wave = __builtin_amdgcn_readfirstlane(tid >> 6), gw = blockIdx.x * NWAVES + wave, NGW = gridDim.x * NWAVES;
    LAS float* scr = (LAS float*)(lds + wave * 16384);
    constexpr int I_IN = 16 * 96, I_OUT = 16 * 32, I_Q = 16 * 8, I_KV = 16 * 16, I_O = 4 * 32, I_G = 16 * 88, I_D = 44 * 32;
    constexpr int PER_LAYER = I_IN + I_OUT + I_Q + I_KV + I_O + 2 * I_G + I_D;
    for (int it = gw; it < DEPTH * PER_LAYER; it += NGW) {
        const int l = it / PER_LAYER; int r = it % PER_LAYER;
        unsigned char* wl = p.ws + WS_W + (size_t)l * W_LAYER;
        if (r < I_IN) { const int kb = r / 96, db = r % 96, ndst = 32 * db; int nsrc, nv;
            if (ndst < 1280) { nsrc = ndst; nv = 32; } else if (ndst < 2816) { nsrc = ndst + 24; nv = 32; } else if (ndst == 2816) { nsrc = 1280; nv = 24; } else { nsrc = 0; nv = 0; }
            transpose_item(p.w_in + (size_t)l * DM * IN_W, IN_W, (bf16*)(wl + WO_IN), DM, 64 * kb, nsrc, ndst, nv, scr, lane); continue; } r -= I_IN;
        if (r < I_OUT) { const int kb = r / 32, nb = r % 32; transpose_item(p.w_out + (size_t)l * DM * DM, DM, (bf16*)(wl + WO_OUT), DM, 64 * kb, 32 * nb, 32 * nb, 32, scr, lane); continue; } r -= I_OUT;
        if (r < I_Q) { const int kb = r / 8, nb = r % 8; transpose_item(p.mem_wq + (size_t)l * DM * 256, 256, (bf16*)(wl + WO_Q), DM, 64 * kb, 32 * nb, 32 * nb, 32, scr, lane); continue; } r -= I_Q;
        if (r < I_KV) { const int kb = r / 16, nb = r % 16; transpose_item(p.mem_wkv + (size_t)l * DM * 512, 512, (bf16*)(wl + WO_KV), DM, 64 * kb, 32 * nb, 32 * nb, 32, scr, lane); continue; } r -= I_KV;
        if (r < I_O) { const int kb = r / 32, nb = r % 32; transpose_item(p.mem_wo + (size_t)l * 256 * DM, DM, (bf16*)(wl + WO_O), 256, 64 * kb, 32 * nb, 32 * nb, 32, scr, lane); continue; } r -= I_O;
        if (r < I_G) { const int kb = r / 88, nb = r % 88; transpose_item(p.ffn_wg + (size_t)l * DM * FFN, FFN, (bf16*)(wl + WO_GU), DM, 64 * kb, 32 * nb, 256 * (nb >> 2) + 32 * (nb & 3), 32, scr, lane); continue; } r -= I_G;
        if (r < I_G) { const int kb = r / 88, nb = r % 88; transpose_item(p.ffn_wu + (size_t)l * DM * FFN, FFN, (bf16*)(wl + WO_GU), DM, 64 * kb, 32 * nb, 256 * (nb >> 2) + 128 + 32 * (nb & 3), 32, scr, lane); continue; } r -= I_G;
        { const int kb = r / 32, nb = r % 32; transpose_item(p.ffn_wd + (size_t)l * FFN * DM, DM, (bf16*)(wl + WO_D), FFN, 64 * kb, 32 * nb, 32 * nb, 32, scr, lane); }
    }
}

template <bool RES, bool XBOUT>
__device__ __forceinline__ void row_pass(const float* xi, const float* h, const float* gpost, float* xo, const float* gpre, bf16* xb, int nrows) {
    const int tid = opaque_tid(), lane = tid & 63, wave = __builtin_amdgcn_readfirstlane(tid >> 6), gw = blockIdx.x * NWAVES + wave, NGW = gridDim.x * NWAVES;
    for (int m = gw; m < nrows; m += NGW) {
        const f32x4* xr = (const f32x4*)(xi + (size_t)m * DM) + lane;
        f32x4 v[4];
#pragma unroll
        for (int j = 0; j < 4; ++j) v[j] = xr[64 * j];
        if (RES) {
            const f32x4* hr = (const f32x4*)(h + (size_t)m * DM) + lane; f32x4 hv[4]; float s = 0.f;
#pragma unroll
            for (int j = 0; j < 4; ++j) { hv[j] = hr[64 * j]; s += (hv[j].x * hv[j].x + hv[j].y * hv[j].y) + (hv[j].z * hv[j].z + hv[j].w * hv[j].w); }
            const float r1 = rsqrtf(wave_sum(s) * (1.f / DM) + RMS_EPS);
            f32x4* xw = (f32x4*)(xo + (size_t)m * DM) + lane;
#pragma unroll
            for (int j = 0; j < 4; ++j) { const f32x4 g = ((const f32x4*)gpost)[lane + 64 * j]; v[j] = v[j] + hv[j] * r1 * g; xw[64 * j] = v[j]; }
        }
        if (XBOUT) {
            float s2 = 0.f;
#pragma unroll
            for (int j = 0; j < 4; ++j) s2 += (v[j].x * v[j].x + v[j].y * v[j].y) + (v[j].z * v[j].z + v[j].w * v[j].w);
            const float r2 = rsqrtf(wave_sum(s2) * (1.f / DM) + RMS_EPS);
            unsigned long long* o8 = (unsigned long long*)(xb + (size_t)m * DM) + lane;
#pragma unroll
            for (int j = 0; j < 4; ++j) { const f32x4 g = ((const f32x4*)gpre)[lane + 64 * j]; const f32x4 y = v[j] * r2 * g;
                o8[64 * j] = (unsigned long long)pk2(y.x, y.y) | ((unsigned long long)pk2(y.z, y.w) << 32); }
        }
    }
}

__device__ __forceinline__ float gelu_tanh(float x) { return 0.5f * x * (1.0f + tanhf(0.7978845608028654f * (x + 0.044715f * x * x * x))); }
__device__ __forceinline__ void compress_item(const Params& p, int l, int item, LAS unsigned char* lds) {
    const int tid = opaque_tid();
    const int b = item / 127, i = item % 127;
    LAS float* flat = (LAS float*)lds;
    LAS float* hid = flat + 4 * 2048;
    const bf16* proj = (const bf16*)(p.ws + WS_PROJ);
    const float* pe = p.cmp_pe + (size_t)l * 32 * 64;
    for (int e = tid; e < 4 * 2048; e += NTHREADS) { const int r = e >> 11, k = e & 2047, pp = k >> 6, d = k & 63, g = r & 1, kv = r >> 1;
        const bf16 v = proj[(size_t)(b * SEQ + 16 * i + pp) * PROJ_LD + (kv ? CVC : CKC) + g * 64 + d];
        flat[e] = __uint_as_float((unsigned)v << 16) + pe[pp * 64 + d]; }
    __syncthreads();
    { const int r = tid >> 7, j = tid & 127, kv = r >> 1;
      const float* w1 = (kv ? p.cv1 : p.ck1) + (size_t)l * 2048 * 128 + j; const LAS float* f = flat + r * 2048;
      float a0 = 0.f, a1 = 0.f, a2 = 0.f, a3 = 0.f;
#pragma unroll 2
      for (int k = 0; k < 2048; k += 4) { a0 += f[k] * w1[(size_t)k * 128]; a1 += f[k + 1] * w1[(size_t)(k + 1) * 128]; a2 += f[k + 2] * w1[(size_t)(k + 2) * 128]; a3 += f[k + 3] * w1[(size_t)(k + 3) * 128]; }
      hid[tid] = gelu_tanh((a0 + a1) + (a2 + a3)); }
    __syncthreads();
    if (tid < 256) { const int r = tid >> 6, e = tid & 63, g = r & 1, kv = r >> 1;
        const float* w2 = (kv ? p.cv2 : p.ck2) + (size_t)l * 128 * 64 + e; const LAS float* hh = hid + r * 128; float a = 0.f;
#pragma unroll 8
        for (int j = 0; j < 128; ++j) a += hh[j] * w2[j * 64];
        float* dst = (float*)(p.ws + (kv ? WS_VCMP : WS_KCMP)); dst[((size_t)(b * 128 + i) * 2 + g) * 64 + e] = a; }
    __syncthreads();
}

struct Soft { float m, l; };
#define ATT_ROW_BF16(kptr, vptr, biasv) do { \
    const u32x4* kp_ = (const u32x4*)(kptr); float s_ = 0.f; \
    _Pragma("unroll") for (int c_ = 0; c_ < 8; ++c_) { const u32x4 kk_ = kp_[c_]; \
        s_ += q[8 * c_ + 0] * bflo(kk_.x) + q[8 * c_ + 1] * bfhi(kk_.x) + q[8 * c_ + 2] * bflo(kk_.y) + q[8 * c_ + 3] * bfhi(kk_.y) + q[8 * c_ + 4] * bflo(kk_.z) + q[8 * c_ + 5] * bfhi(kk_.z) + q[8 * c_ + 6] * bflo(kk_.w) + q[8 * c_ + 7] * bfhi(kk_.w); } \
    s_ = s_ * 0.125f + (biasv); \
    if (s_ > m) { const float f_ = __expf(m - s_); l *= f_; _Pragma("unroll") for (int d_ = 0; d_ < 64; ++d_) o[d_] *= f_; m = s_; } \
    const float p_ = __expf(s_ - m); l += p_; const u32x4* vp_ = (const u32x4*)(vptr); \
    _Pragma("unroll") for (int c_ = 0; c_ < 8; ++c_) { const u32x4 vv_ = vp_[c_]; \
        o[8 * c_ + 0] += p_ * bflo(vv_.x); o[8 * c_ + 1] += p_ * bfhi(vv_.x); o[8 * c_ + 2] += p_ * bflo(vv_.y); o[8 * c_ + 3] += p_ * bfhi(vv_.y); \
        o[8 * c_ + 4] += p_ * bflo(vv_.z); o[8 * c_ + 5] += p_ * bfhi(vv_.z); o[8 * c_ + 6] += p_ * bflo(vv_.w); o[8 * c_ + 7] += p_ * bfhi(vv_.w); } } while (0)

__device__ __forceinline__ void nsa_item(const Params& p, int ly, int item, LAS unsigned char* lds) {
    const int tid = opaque_tid();
    const int b = item >> 5, ch = item & 31, lane = tid & 63, wave = __builtin_amdgcn_readfirstlane(tid >> 6);
    LAS float* PS = (LAS float*)lds;
    LAS float* IMP = PS + 64 * 2 * 128;
    LAS unsigned* SELM = (LAS unsigned*)(IMP + 64 * 2 * 32);
    LAS float* RB = (LAS float*)(SELM + 128);
    LAS int* BK = (LAS int*)(RB + 256);
    const bf16* proj = (const bf16*)(p.ws + WS_PROJ);
    bf16* xb = (bf16*)(p.ws + WS_XB);
    for (int e = tid; e < 64 * 2 * 128; e += NTHREADS) PS[e] = 0.f;
    if (tid < 256) RB[tid] = p.rel_bias[tid];
    if (tid < 128) BK[tid] = T5_BUCKET[tid];
    {
        const float* cw = p.conv_w + (size_t)ly * 3 * 512 + lane * 8; const float* gn = p.gn_conv + (size_t)ly * 512 + lane * 8;
        for (int tq = wave; tq < 64; tq += NWAVES) {
            const int t = 64 * ch + tq; const size_t row = (size_t)b * SEQ + t;
            float y[8];
#pragma unroll
            for (int e = 0; e < 8; ++e) y[e] = 0.f;
#pragma unroll
            for (int k = 0; k < 3; ++k) if (t - k >= 0) {
                const u32x4 cc = *(const u32x4*)(proj + (row - k) * PROJ_LD + CCC + lane * 8), cx = *(const u32x4*)(proj + (row - k) * PROJ_LD + CCX + lane * 8);
                const float* w = cw + k * 512;
                y[0] += w[0] * bflo(cc.x) * bflo(cx.x); y[1] += w[1] * bfhi(cc.x) * bfhi(cx.x); y[2] += w[2] * bflo(cc.y) * bflo(cx.y); y[3] += w[3] * bfhi(cc.y) * bfhi(cx.y);
                y[4] += w[4] * bflo(cc.z) * bflo(cx.z); y[5] += w[5] * bfhi(cc.z) * bfhi(cx.z); y[6] += w[6] * bflo(cc.w) * bflo(cx.w); y[7] += w[7] * bfhi(cc.w) * bfhi(cx.w); }
            const u32x4 cb = *(const u32x4*)(proj + row * PROJ_LD + CCB + lane * 8);
            y[0] *= bflo(cb.x); y[1] *= bfhi(cb.x); y[2] *= bflo(cb.y); y[3] *= bfhi(cb.y); y[4] *= bflo(cb.z); y[5] *= bfhi(cb.z); y[6] *= bflo(cb.w); y[7] *= bfhi(cb.w);
            float ss = 0.f;
#pragma unroll
            for (int e = 0; e < 8; ++e) ss += y[e] * y[e];
            const float r = rsqrtf(wave_sum(ss) * (1.f / 512.f) + RMS_EPS);
            u32x4 w; w.x = pk2(y[0] * r * gn[0], y[1] * r * gn[1]); w.y = pk2(y[2] * r * gn[2], y[3] * r * gn[3]); w.z = pk2(y[4] * r * gn[4], y[5] * r * gn[5]); w.w = pk2(y[6] * r * gn[6], y[7] * r * gn[7]);
            *(u32x4*)(xb + row * DM + 512 + lane * 8) = w;
        }
    }
    __syncthreads();
    const int ql = tid >> 3, h = tid & 7, g = h >> 2, t = 64 * ch + ql; const size_t row = (size_t)b * SEQ + t;
    float q[64], o[64];
    float* outp = (float*)(p.ws + WS_H) + row * DM + h * 64;
    { const u32x4* qp = (const u32x4*)(proj + row * PROJ_LD + CQ + h * 64);
#pragma unroll
      for (int c = 0; c < 8; ++c) { const u32x4 v = qp[c]; q[8 * c] = bflo(v.x); q[8 * c + 1] = bfhi(v.x); q[8 * c + 2] = bflo(v.y); q[8 * c + 3] = bfhi(v.y); q[8 * c + 4] = bflo(v.z); q[8 * c + 5] = bfhi(v.z); q[8 * c + 6] = bflo(v.w); q[8 * c + 7] = bfhi(v.w); } }
    const bf16* gl = proj + row * PROJ_LD + CGL + h * 3;
    const float g0 = 1.f / (1.f + __expf(-__uint_as_float((unsigned)gl[0] << 16))), g1 = 1.f / (1.f + __expf(-__uint_as_float((unsigned)gl[1] << 16))), g2 = 1.f / (1.f + __expf(-__uint_as_float((unsigned)gl[2] << 16)));
    const LAS float* rb = RB + h * 32;
    {
        const int ncv = (t >= 31) ? ((t - 15) >> 4) : 0, nmax = 4 * ch + 3 > 127 ? 127 : 4 * ch + 3;
        const float* kc = (const float*)(p.ws + WS_KCMP) + ((size_t)b * 128 * 2 + g) * 64; const float* vc = (const float*)(p.ws + WS_VCMP) + ((size_t)b * 128 * 2 + g) * 64;
        float m = -1e30f, l = 0.f;
        for (int n = 0; n < ncv; ++n) { const f32x4* kp = (const f32x4*)(kc + (size_t)n * 128); float s = 0.f;
#pragma unroll
            for (int c = 0; c < 16; ++c) { const f32x4 kk = kp[c]; s += q[4 * c] * kk.x + q[4 * c + 1] * kk.y + q[4 * c + 2] * kk.z + q[4 * c + 3] * kk.w; }
            s = s * 0.125f + rb[BK[min(t - 16 * n - 31, 127)]];
            if (s > m) { l *= __expf(m - s); m = s; } l += __expf(s - m); }
        const float il = l > 0.f ? 1.f / l : 0.f;
#pragma unroll
        for (int d = 0; d < 64; ++d) o[d] = 0.f;
        for (int n = 0; n < nmax; ++n) { float pn = 0.f;
            if (n < ncv) { const f32x4* kp = (const f32x4*)(kc + (size_t)n * 128); float s = 0.f;
#pragma unroll
                for (int c = 0; c < 16; ++c) { const f32x4 kk = kp[c]; s += q[4 * c] * kk.x + q[4 * c + 1] * kk.y + q[4 * c + 2] * kk.z + q[4 * c + 3] * kk.w; }
                s = s * 0.125f + rb[BK[min(t - 16 * n - 31, 127)]];
                pn = __expf(s - m) * il;
                const f32x4* vp = (const f32x4*)(vc + (size_t)n * 128);
#pragma unroll
                for (int c = 0; c < 16; ++c) { const f32x4 vv = vp[c]; o[4 * c] += pn * vv.x; o[4 * c + 1] += pn * vv.y; o[4 * c + 2] += pn * vv.z; o[4 * c + 3] += pn * vv.w; } }
            float ps = pn; ps += __shfl_xor(ps, 1); ps += __shfl_xor(ps, 2);
            if ((h & 3) == 0) PS[(ql * 2 + g) * 128 + n] = ps; }
#pragma unroll
        for (int c = 0; c < 16; ++c) ((f32x4*)outp)[c] = (f32x4){g0 * o[4 * c], g0 * o[4 * c + 1], g0 * o[4 * c + 2], g0 * o[4 * c + 3]};
    }
    __syncthreads();
    for (int e = tid; e < 64 * 2 * 32; e += NTHREADS) { const int j = e & 31; const LAS float* ps = PS + (e >> 5) * 128 + 4 * j;
        IMP[e] = (j > 0 ? 0.5f * ps[-1] : 0.f) + ps[0] + ps[1] + ps[2] + 0.5f * ps[3]; }
    __syncthreads();
    if (tid < 128) { unsigned mask;
        if (ch < 8) mask = (1u << (ch + 1)) - 1u;
        else { mask = 1u | (1u << ch) | (1u << (ch - 1)); const LAS float* im = IMP + tid * 32;
            for (int r = 0; r < 5; ++r) { int best = 1; float bv = -1.f;
                for (int j = 1; j <= ch - 2; ++j) { const float v = im[j]; if (!((mask >> j) & 1u) && v > bv) { bv = v; best = j; } }
                mask |= 1u << best; } }
        SELM[tid] = mask; }
    __syncthreads();
    {
        unsigned mask = SELM[ql * 2 + g]; const int cnt = ch < 8 ? ch + 1 : 8;
        float m = -1e30f, l = 0.f;
#pragma unroll
        for (int d = 0; d < 64; ++d) o[d] = 0.f;
        for (int it = 0; it < cnt; ++it) { const int j = __builtin_ctz(mask); mask &= mask - 1u;
            const bf16* kb = proj + ((size_t)b * SEQ + 64 * j) * PROJ_LD + CKS + g * 64;
            for (int kk = 0; kk < 64; ++kk) { const int dist = t - (64 * j + kk);
                if (dist >= 0) ATT_ROW_BF16(kb + (size_t)kk * PROJ_LD, kb + (size_t)kk * PROJ_LD + (CVS - CKS), rb[BK[min(dist, 127)]]); } }
        const float w = g1 / l;
#pragma unroll
        for (int c = 0; c < 16; ++c) { f32x4 a = ((f32x4*)outp)[c]; a.x += w * o[4 * c]; a.y += w * o[4 * c + 1]; a.z += w * o[4 * c + 2]; a.w += w * o[4 * c + 3]; ((f32x4*)outp)[c] = a; }
    }
    {
        float m = -1e30f, l = 0.f;
#pragma unroll
        for (int d = 0; d < 64; ++d) o[d] = 0.f;
        for (int kk = 0; kk < 256; ++kk) { const int pos = t - 255 + kk;
            if (pos >= 0) { const bf16* kb = proj + ((size_t)b * SEQ + pos) * PROJ_LD + CKW + g * 64; ATT_ROW_BF16(kb, kb + (CVW - CKW), rb[BK[min(255 - kk, 127)]]); } }
        const float w = g2 / l;
#pragma unroll
        for (int c = 0; c < 16; ++c) { const f32x4 a = ((f32x4*)outp)[c]; o[4 * c] = a.x + w * o[4 * c]; o[4 * c + 1] = a.y + w * o[4 * c + 1]; o[4 * c + 2] = a.z + w * o[4 * c + 2]; o[4 * c + 3] = a.w + w * o[4 * c + 3]; }
    }
    { float ss = 0.f;
#pragma unroll
      for (int d = 0; d < 64; ++d) ss += o[d] * o[d];
      ss += __shfl_xor(ss, 1); ss += __shfl_xor(ss, 2); ss += __shfl_xor(ss, 4);
      const float r = rsqrtf(ss * (1.f / 512.f) + RMS_EPS); const float* gn = p.gn_nsa + (size_t)ly * 512 + h * 64;
      u32x4* dst = (u32x4*)(xb + row * DM + h * 64);
#pragma unroll
      for (int c = 0; c < 8; ++c) { u32x4 w; w.x = pk2(o[8 * c] * r * gn[8 * c], o[8 * c + 1] * r * gn[8 * c + 1]); w.y = pk2(o[8 * c + 2] * r * gn[8 * c + 2], o[8 * c + 3] * r * gn[8 * c + 3]);
          w.z = pk2(o[8 * c + 4] * r * gn[8 * c + 4], o[8 * c + 5] * r * gn[8 * c + 5]); w.w = pk2(o[8 * c + 6] * r * gn[8 * c + 6], o[8 * c + 7] * r * gn[8 * c + 7]); dst[c] = w; } }
    __syncthreads();
}

__device__ __forceinline__ void memattn_item(const Params& p, int ly, int item) {
    const int tid = opaque_tid();
    const int b = item >> 4, qt = item & 15, ql = tid >> 2, hm = tid & 3; const size_t row = (size_t)b * SEQ + 128 * qt + ql;
    const bf16* qm = (const bf16*)(p.ws + WS_QM); const bf16* kv = (const bf16*)(p.ws + WS_MEMKV) + (size_t)ly * 4096 * 512 + (size_t)b * MEML * 512 + hm * 64;
    float q[64], o[64];
    { const u32x4* qp = (const u32x4*)(qm + row * 256 + hm * 64);
#pragma unroll
      for (int c = 0; c < 8; ++c) { const u32x4 v = qp[c]; q[8 * c] = bflo(v.x); q[8 * c + 1] = bfhi(v.x); q[8 * c + 2] = bflo(v.y); q[8 * c + 3] = bfhi(v.y); q[8 * c + 4] = bflo(v.z); q[8 * c + 5] = bfhi(v.z); q[8 * c + 6] = bflo(v.w); q[8 * c + 7] = bfhi(v.w); } }
    float m = -1e30f, l = 0.f;
#pragma unroll
    for (int d = 0; d < 64; ++d) o[d] = 0.f;
    for (int k = 0; k < MEML; ++k) ATT_ROW_BF16(kv + (size_t)k * 512, kv + (size_t)k * 512 + 256, 0.f);
    const float il = 1.f / l;
    u32x4* dst = (u32x4*)((bf16*)(p.ws + WS_OM) + row * 256 + hm * 64);
#pragma unroll
    for (int c = 0; c < 8; ++c) { u32x4 w; w.x = pk2(o[8 * c] * il, o[8 * c + 1] * il); w.y = pk2(o[8 * c + 2] * il, o[8 * c + 3] * il); w.z = pk2(o[8 * c + 4] * il, o[8 * c + 5] * il); w.w = pk2(o[8 * c + 6] * il, o[8 * c + 7] * il); dst[c] = w; }
}

template <class Epi>
__device__ __forceinline__ void run_gemm(LAS unsigned char* lds, const bf16* A, const bf16* Bt, int M, int N, int K, const Epi& E) {
    pg8::Gemm g{A, Bt, M, N, K}; pg8::StaticOrder S; S.init(M, N, (int)gridDim.x, (int)blockIdx.x);
    pg8::gemm_phase<Epi, pg8::StaticOrder, true, true>(lds, g, S, E);
}

__global__ void __launch_bounds__(NTHREADS, 2) hymba_fwd(Params p) {
    extern __shared__ __attribute__((aligned(16))) unsigned char lds_raw[];
    LAS unsigned char* lds = (LAS unsigned char*)lds_raw;
    cg::grid_group grid = cg::this_grid();
    const int G = gridDim.x;
    unsigned char* ws = p.ws;
    bf16* XB = (bf16*)(ws + WS_XB); float* H = (float*)(ws + WS_H); bf16* PROJ = (bf16*)(ws + WS_PROJ); bf16* HID = PROJ;
    bf16* QM = (bf16*)(ws + WS_QM); bf16* OM = (bf16*)(ws + WS_OM); bf16* MEMN = (bf16*)(ws + WS_MEMN); bf16* MEMKV = (bf16*)(ws + WS_MEMKV);
    int ph = 0;
#define PHASE_BEGIN if (ph >= p.ph_lo && ph < p.ph_hi) {
#define PHASE_END   if (ph + 1 < p.ph_hi) grid.sync(); } ++ph;

    PHASE_BEGIN
        weights_phase(p, lds);
        row_pass<false, true>(p.x, nullptr, nullptr, nullptr, p.norms, XB, T);
        for (int l = 0; l < DEPTH; ++l) row_pass<false, true>(p.mem, nullptr, nullptr, nullptr, p.mem_norm + l * DM, MEMN + (size_t)l * 4096 * DM, BATCH * MEML);
        __syncthreads();
    PHASE_END

    for (int l = 0; l < DEPTH; ++l) {
        const unsigned char* wl = ws + WS_W + (size_t)l * W_LAYER;
        const float* nl = p.norms + (size_t)l * 6 * DM;
        const float* xin = (l == 0) ? p.x : p.out;
        PHASE_BEGIN
            run_gemm(lds, XB, (const bf16*)(wl + WO_IN), T, PROJ_LD, DM, pg8::EpiStoreBf16{PROJ, PROJ_LD});
            run_gemm(lds, MEMN + (size_t)l * 4096 * DM, (const bf16*)(wl + WO_KV), BATCH * MEML, 512, DM, pg8::EpiStoreBf16{MEMKV + (size_t)l * 4096 * 512, 512});
        PHASE_END
        PHASE_BEGIN
            for (int it = blockIdx.x; it < BATCH * 127; it += G) compress_item(p, l, it, lds);
        PHASE_END
        PHASE_BEGIN
            for (int it = blockIdx.x; it < BATCH * 32; it += G) nsa_item(p, l, (it & ~31) | (it < 256 ? 31 - (it & 31) : (it & 31)), lds);
        PHASE_END
        PHASE_BEGIN
            run_gemm(lds, XB, (const bf16*)(wl + WO_OUT), T, DM, DM, pg8::EpiStoreF32{H, DM});
        PHASE_END
        PHASE_BEGIN
            row_pass<true, true>(xin, H, nl + DM, p.out, nl + 2 * DM, XB, T);
        PHASE_END
        PHASE_BEGIN
            run_gemm(lds, XB, (const bf16*)(wl + WO_Q), T, 256, DM, pg8::EpiStoreBf16{QM, 256});
        PHASE_END
        PHASE_BEGIN
            for (int it = blockIdx.x; it < BATCH * 16; it += G) memattn_item(p, l, it);
        PHASE_END
        PHASE_BEGIN
            run_gemm(lds, OM, (const bf16*)(wl + WO_O), T, DM, 256, pg8::EpiStoreF32{H, DM});
        PHASE_END
        PHASE_BEGIN
            row_pass<true, true>(p.out, H, nl + 3 * DM, p.out, nl + 4 * DM, XB, T);
        PHASE_END
        PHASE_BEGIN
            run_gemm(lds, XB, (const bf16*)(wl + WO_GU), T, 2 * FFN, DM, pg8::EpiSwiGLU{HID, FFN});
        PHASE_END
        PHASE_BEGIN
            run_gemm(lds, HID, (const bf16*)(wl + WO_D), T, DM, FFN, pg8::EpiStoreF32{H, DM});
        PHASE_END
        PHASE_BEGIN
            if (l + 1 < DEPTH) row_pass<true, true>(p.out, H, nl + 5 * DM, p.out, nl + 6 * DM, XB, T);
            else row_pass<true, false>(p.out, H, nl + 5 * DM, p.out, nullptr, nullptr, T);
        PHASE_END
    }
}
constexpr int N_PHASES = 1 + DEPTH * 12;

extern "C" void kernel_launch(void* const* d_in, const int* in_sizes, int n_in, void* d_out, int out_size, void* d_ws, size_t ws_size, hipStream_t stream) {
    static int grid = 0;
    if (grid == 0) {
        if (n_in != 21 || in_sizes[0] != T * DM || out_size != T * DM || ws_size < WS_END) { fprintf(stderr, "kernel_launch: unexpected problem (n_in %d, in0 %d, out %d, ws %zu < %zu)\n", n_in, n_in > 0 ? in_sizes[0] : -1, out_size, ws_size, (size_t)WS_END); grid = -1; return; }
        int dev = 0, cus = 0, per_cu = 0;
        if (hipGetDevice(&dev) != hipSuccess || hipDeviceGetAttribute(&cus, hipDeviceAttributeMultiprocessorCount, dev) != hipSuccess) { grid = -1; return; }
        if (hipFuncSetAttribute((const void*)hymba_fwd, hipFuncAttributeMaxDynamicSharedMemorySize, LDS_BYTES) != hipSuccess) { fprintf(stderr, "kernel_launch: hipFuncSetAttribute failed\n"); grid = -1; return; }
        if (hipOccupancyMaxActiveBlocksPerMultiprocessor(&per_cu, (const void*)hymba_fwd, NTHREADS, LDS_BYTES) != hipSuccess || per_cu < 1) { fprintf(stderr, "kernel_launch: occupancy query says %d blocks per CU\n", per_cu); grid = -1; return; }
        grid = cus;
    }
    if (grid < 0) return;
    Params p{};
    const float** fp = (const float**)&p;
    for (int i = 0; i < 21; ++i) fp[i] = (const float*)d_in[i];
    p.out = (float*)d_out; p.ws = (unsigned char*)d_ws;
#ifndef N_LAUNCH_PER_PHASE
    p.ph_lo = 0; p.ph_hi = N_PHASES;
    { void* args[] = {&p};
      hipError_t e = hipLaunchCooperativeKernel((void*)hymba_fwd, dim3(grid), dim3(NTHREADS), args, LDS_BYTES, stream);
      if (e != hipSuccess) fprintf(stderr, "cooperative launch failed: %s (grid %d)\n", hipGetErrorString(e), grid); }
#else
    for (int ph = 0; ph < N_PHASES; ++ph) { p.ph_lo = ph; p.ph_hi = ph + 1; void* args[] = {&p};
      hipError_t e = hipLaunchCooperativeKernel((void*)hymba_fwd, dim3(grid), dim3(NTHREADS), args, LDS_BYTES, stream);
      if (e != hipSuccess) { fprintf(stderr, "cooperative launch failed: %s (grid %d)\n", hipGetErrorString(e), grid); break; } }
#endif
}
```

```cpp
#include <hip/hip_runtime.h>
#include <hip/hip_cooperative_groups.h>
#include <cstdio>
#include <cstdint>
namespace cg = cooperative_groups;
namespace pg8 {
#define PG8_LAS __attribute__((address_space(3)))
typedef unsigned short bf16_t;
typedef short bf16x8 __attribute__((ext_vector_type(8)));
typedef float f32x4 __attribute__((ext_vector_type(4)));
typedef unsigned u32x4 __attribute__((ext_vector_type(4)));
constexpr int BM = 256, BK = 64, HALF = 128, HTB = HALF * BK * 2  , STAGE_BYTES = 8 * HTB, NXCD = 8, WGM = 8;

__host__ __device__ __forceinline__ int lds_byte(int r, int c) { const int st = (r >> 4) * 2 + (c >> 5), rr = r & 15, cc = c & 31, ob = rr * 64 + cc * 2; return st * 1024 + (ob ^ (((ob >> 9) & 1) << 5)); }
__host__ __device__ __forceinline__ void stage_rc(int b, int& R, int& C) { const int st = b / 1024, sb = b % 1024, swz = sb ^ (((sb >> 9) & 1) << 5); R = (st >> 1) * 16 + swz / 64; C = (st & 1) * 32 + (swz % 64) / 2; }
__host__ __device__ __forceinline__ int perm32(int rho) { const int n = rho >> 4, i = rho & 15; return 8 * (i >> 2) + 4 * n + (i & 3); }

struct Unit { int pm, pn; };
struct Gemm { const bf16_t* A; const bf16_t* Bt; int M, N, K; };

struct StaticOrder {
    int nM, nN, nwg, G, c;
    __host__ __device__ void init(int M, int N, int G_, int c_) { nM = M / BM; nN = N / BM; nwg = nM * nN; G = G_; c = c_; }
    __host__ __device__ bool next(int i, Unit& u) const {
        const long L = (long)i * G + c; if (L >= nwg) return false;
        int wgid = (int)L; { const int q = nwg / NXCD, r = nwg % NXCD, xcd = wgid % NXCD, off = wgid / NXCD; wgid = (xcd < r ? xcd * (q + 1) : r * (q + 1) + (xcd - r) * q) + off; }
        const int nig = WGM * nN, gid = wgid / nig, fm = gid * WGM, gsz = (nM - fm) < WGM ? (nM - fm) : WGM;
        u.pm = fm + ((wgid % nig) % gsz); u.pn = (wgid % nig) / gsz; return true;
    }
    __device__ __forceinline__ void a_ready(const Unit&) const {}
    __device__ __forceinline__ void done(const Unit&) const {}
};

__device__ __forceinline__ unsigned cvt_pk_bf16(float lo, float hi) { unsigned r; asm volatile("v_cvt_pk_bf16_f32 %0, %1, %2" : "=v"(r) : "v"(lo), "v"(hi)); return r; }
typedef float f32x2 __attribute__((ext_vector_type(2)));
struct EpiStoreBf16 {
    static constexpr bool PERM = true, AFTER_DRAIN = false;
    bf16_t* O; int ldc; int scale_tiles; float scale;
    __device__ __forceinline__ void operator()(const f32x4 (&acc)[2][2][4][2], const Unit& u, int wr, int wc, int fr, int fq) const {
        const int row0 = u.pm * BM + wr * 64 + fr, col0 = u.pn * BM + wc * 32 + 8 * fq; const float sc = u.pn < scale_tiles ? scale : 1.f;
#pragma unroll
        for (int ai = 0; ai < 2; ++ai)
#pragma unroll
            for (int m = 0; m < 4; ++m) { bf16_t* rowp = O + (size_t)(row0 + ai * HALF + m * 16) * ldc + col0;
#pragma unroll
                for (int bj = 0; bj < 2; ++bj) { const f32x4 v0 = acc[ai][bj][m][0] * sc, v1 = acc[ai][bj][m][1] * sc;
                    u32x4 w; w.x = cvt_pk_bf16(v0[0], v0[1]); w.y = cvt_pk_bf16(v0[2], v0[3]); w.z = cvt_pk_bf16(v1[0], v1[1]); w.w = cvt_pk_bf16(v1[2], v1[3]);
                    *(u32x4*)(rowp + bj * HALF) = w; } }
    }
};
struct EpiStoreF32 {
    static constexpr bool PERM = true, AFTER_DRAIN = false;
    float* O; int ldc;
    __device__ __forceinline__ void operator()(const f32x4 (&acc)[2][2][4][2], const Unit& u, int wr, int wc, int fr, int fq) const {
        const int row0 = u.pm * BM + wr * 64 + fr, col0 = u.pn * BM + wc * 32 + 8 * fq;
#pragma unroll
        for (int ai = 0; ai < 2; ++ai)
#pragma unroll
            for (int m = 0; m < 4; ++m) { float* rowp = O + (size_t)(row0 + ai * HALF + m * 16) * ldc + col0;
#pragma unroll
                for (int bj = 0; bj < 2; ++bj) { *(f32x4*)(rowp + bj * HALF) = acc[ai][bj][m][0]; *(f32x4*)(rowp + bj * HALF + 4) = acc[ai][bj][m][1]; } }
    }
};
struct EpiSwiGLU {
    static constexpr bool PERM = true, AFTER_DRAIN = false;
    bf16_t* O; int ldc;
    __device__ __forceinline__ void operator()(const f32x4 (&acc)[2][2][4][2], const Unit& u, int wr, int wc, int fr, int fq) const {
        const int row0 = u.pm * BM + wr * 64 + fr, col0 = u.pn * HALF + wc * 32 + 8 * fq;
#pragma unroll
        for (int ai = 0; ai < 2; ++ai)
#pragma unroll
            for (int m = 0; m < 4; ++m) { bf16_t* rowp = O + (size_t)(row0 + ai * HALF + m * 16) * ldc + col0;
                float h[8];
#pragma unroll
                for (int n = 0; n < 2; ++n)
#pragma unroll
                    for (int i = 0; i < 4; ++i) { const float g = acc[ai][0][m][n][i], up = acc[ai][1][m][n][i]; h[4 * n + i] = g * up / (1.0f + __expf(-g)); }
                u32x4 w; w.x = cvt_pk_bf16(h[0], h[1]); w.y = cvt_pk_bf16(h[2], h[3]); w.z = cvt_pk_bf16(h[4], h[5]); w.w = cvt_pk_bf16(h[6], h[7]);
                *(u32x4*)rowp = w; }
    }
};
template <class Epi, class Sched, bool ALIGN_EPI = false, bool SP2 = false>
__device__ __forceinline__ void gemm_phase(PG8_LAS unsigned char* lds, const Gemm g, const Sched& S, const Epi& E) {
    int tid_raw = __builtin_amdgcn_mbcnt_hi(~0u, __builtin_amdgcn_mbcnt_lo(~0u, 0u)); asm volatile("" : "+v"(tid_raw)); tid_raw += 64 * __builtin_amdgcn_readfirstlane((int)(threadIdx.x >> 6));
    const int tid = tid_raw, wid = __builtin_amdgcn_readfirstlane(tid >> 6), lane = tid & 63, wr = wid >> 2, wc = wid & 3, fr = lane & 15, fq = lane >> 4;
    const int K = g.K, nt = K / BK;
    unsigned voffA[2], voffB[2];
#pragma unroll
    for (int i = 0; i < 2; ++i) { int R, C; stage_rc(tid * 16 + i * 8192, R, C); const int Rb = Epi::PERM ? ((R & ~31) + perm32(R & 31)) : R;
        voffA[i] = (unsigned)(R * K + C) * 2u; voffB[i] = (unsigned)(Rb * K + C) * 2u; }
    const size_t kstep = (size_t)(BK * 2);
    const size_t hstep = (size_t)HALF * K * 2;
    const size_t tstep = 2 * hstep;
    const unsigned ldsw = (unsigned)wid * 1024u;
    const int aoff = lds_byte(wr * 64 + fr, fq * 8), boff = lds_byte(wc * 32 + fr, fq * 8);
#define PG8_SA(b, h) (((b) * 2 + (h)) * HTB)
#define PG8_SB(b, h) ((4 + (b) * 2 + (h)) * HTB)
#define PG8_STAGE(bufoff, gbase, voff) do { _Pragma("unroll") for (int _i = 0; _i < 2; ++_i) \
        __builtin_amdgcn_global_load_lds((const unsigned*)((const char*)(gbase) + (voff)[_i]), (PG8_LAS unsigned*)(lds + (bufoff) + ldsw + _i * 8192), 16, 0, 0); } while (0)
#define PG8_LDA(dst, b, h) do { _Pragma("unroll") for (int m = 0; m < 4; ++m) _Pragma("unroll") for (int k = 0; k < 2; ++k) dst[m][k] = *(const PG8_LAS bf16x8*)(lds + PG8_SA(b, h) + aoff + m * 2048 + k * 1024); } while (0)
#define PG8_LDB(dst, b, h) do { _Pragma("unroll") for (int n = 0; n < 2; ++n) _Pragma("unroll") for (int k = 0; k < 2; ++k) dst[n][k] = *(const PG8_LAS bf16x8*)(lds + PG8_SB(b, h) + boff + n * 2048 + k * 1024); } while (0)
#define PG8_MMA(ai, bj, At, Bt) do { __builtin_amdgcn_s_setprio(1); _Pragma("unroll") for (int m = 0; m < 4; ++m) _Pragma("unroll") for (int n = 0; n < 2; ++n) _Pragma("unroll") for (int k = 0; k < 2; ++k) \
        acc[ai][bj][m][n] = __builtin_amdgcn_mfma_f32_16x16x32_bf16(Bt[n][k], At[m][k], acc[ai][bj][m][n], 0, 0, 0); __builtin_amdgcn_s_setprio(0); } while (0)
#define PG8_WAIT_V(n) asm volatile("s_waitcnt vmcnt(" #n ")" ::: "memory")
#define PG8_WAIT_L(n) asm volatile("s_waitcnt lgkmcnt(" #n ")" ::: "memory")
#define PG8_BAR __builtin_amdgcn_s_barrier()
#define PG8_SCHED __builtin_amdgcn_sched_barrier(0)
    Unit cur, nxt; int ui = 0;
    if (!S.next(0, cur)) return;
    f32x4 acc[2][2][4][2];
#pragma unroll
    for (int a = 0; a < 2; ++a)
#pragma unroll
        for (int b = 0; b < 2; ++b)
#pragma unroll
            for (int m = 0; m < 4; ++m)
#pragma unroll
                for (int n = 0; n < 2; ++n) acc[a][b][m][n] = (f32x4){0.f, 0.f, 0.f, 0.f};
    bf16x8 At[4][2], B0[2][2], B1[2][2];
    const char* cA = (const char*)g.A + (size_t)cur.pm * tstep; const char* cB = (const char*)g.Bt + (size_t)cur.pn * tstep;
    S.a_ready(cur);
    if constexpr (SP2) {
        PG8_STAGE(PG8_SB(0, 0), cB, voffB); PG8_STAGE(PG8_SB(0, 1), cB + hstep, voffB); PG8_STAGE(PG8_SA(0, 0), cA, voffA); PG8_STAGE(PG8_SA(0, 1), cA + hstep, voffA);
        if (wr == 1) PG8_BAR;
        PG8_WAIT_V(2); PG8_BAR;
        PG8_STAGE(PG8_SB(1, 0), cB + kstep, voffB); PG8_STAGE(PG8_SA(1, 0), cA + kstep, voffA); PG8_STAGE(PG8_SB(1, 1), cB + hstep + kstep, voffB);
        PG8_WAIT_V(6); PG8_BAR;
    } else {
        PG8_STAGE(PG8_SB(0, 0), cB, voffB); PG8_STAGE(PG8_SA(0, 0), cA, voffA); PG8_STAGE(PG8_SB(0, 1), cB + hstep, voffB); PG8_STAGE(PG8_SA(0, 1), cA + hstep, voffA);
        if (wr == 1) PG8_BAR;
        PG8_WAIT_V(4); PG8_BAR;
        PG8_STAGE(PG8_SB(1, 0), cB + kstep, voffB); PG8_STAGE(PG8_SA(1, 0), cA + kstep, voffA); PG8_STAGE(PG8_SB(1, 1), cB + hstep + kstep, voffB);
        PG8_WAIT_V(6); PG8_BAR;
    }
    for (;;) {
        const bool has_next = S.next(ui + 1, nxt);
        const char* nA = has_next ? (const char*)g.A + (size_t)nxt.pm * tstep : cA; const char* nB = has_next ? (const char*)g.Bt + (size_t)nxt.pn * tstep : cB;
        for (int t = 0; t < nt; t += 2) {
            const bool last = (t == nt - 2);
            const char* a1 = cA + (size_t)(t + 1) * kstep;
            const char* a2 = last ? nA : cA + (size_t)(t + 2) * kstep; const char* b2 = last ? nB : cB + (size_t)(t + 2) * kstep;
            const char* a3 = a2 + kstep; const char* b3 = b2 + kstep;
            if (last && has_next) S.a_ready(nxt);
            if constexpr (SP2) {
            PG8_LDB(B0, 0, 0); PG8_LDB(B1, 0, 1); PG8_SCHED; PG8_LDA(At, 0, 0); PG8_STAGE(PG8_SA(1, 1), a1 + hstep, voffA);
            PG8_WAIT_V(8); PG8_WAIT_L(0); PG8_BAR; PG8_MMA(0, 0, At, B0); PG8_MMA(0, 1, At, B1); PG8_BAR; PG8_SCHED;
            PG8_LDA(At, 0, 1); PG8_STAGE(PG8_SB(0, 0), b2, voffB); PG8_STAGE(PG8_SB(0, 1), b2 + hstep, voffB); PG8_STAGE(PG8_SA(0, 0), a2, voffA);
            PG8_WAIT_V(8); PG8_WAIT_L(0); PG8_BAR; PG8_MMA(1, 0, At, B0); PG8_MMA(1, 1, At, B1); PG8_BAR; PG8_SCHED;
            PG8_LDB(B0, 1, 0); PG8_LDB(B1, 1, 1); PG8_SCHED; PG8_LDA(At, 1, 0); PG8_STAGE(PG8_SA(0, 1), a2 + hstep, voffA);
            PG8_WAIT_V(8); PG8_WAIT_L(0); PG8_BAR; PG8_MMA(0, 0, At, B0); PG8_MMA(0, 1, At, B1); PG8_BAR; PG8_SCHED;
            PG8_LDA(At, 1, 1); PG8_STAGE(PG8_SB(1, 0), b3, voffB); PG8_STAGE(PG8_SB(1, 1), b3 + hstep, voffB); PG8_STAGE(PG8_SA(1, 0), a3, voffA);
            PG8_WAIT_V(8); PG8_WAIT_L(0); PG8_BAR; PG8_MMA(1, 0, At, B0); PG8_MMA(1, 1, At, B1); PG8_BAR; PG8_SCHED;
            } else {
            PG8_LDB(B0, 0, 0); PG8_SCHED; PG8_LDA(At, 0, 0); PG8_STAGE(PG8_SA(1, 1), a1 + hstep, voffA);
            PG8_WAIT_L(8); PG8_BAR; PG8_WAIT_L(0); PG8_MMA(0, 0, At, B0); PG8_BAR; PG8_SCHED;
            PG8_LDB(B1, 0, 1); PG8_STAGE(PG8_SB(0, 0), b2, voffB);
            PG8_BAR; PG8_WAIT_L(0); PG8_MMA(0, 1, At, B1); PG8_BAR;
            PG8_LDA(At, 0, 1); PG8_STAGE(PG8_SA(0, 0), a2, voffA);
            PG8_BAR; PG8_WAIT_L(0); PG8_MMA(1, 0, At, B0); PG8_BAR; PG8_SCHED;
            PG8_STAGE(PG8_SB(0, 1), b2 + hstep, voffB);
            PG8_WAIT_V(6); PG8_BAR; PG8_MMA(1, 1, At, B1); PG8_BAR;
            PG8_LDB(B0, 1, 0); PG8_SCHED; PG8_LDA(At, 1, 0); PG8_STAGE(PG8_SA(0, 1), a2 + hstep, voffA);
            PG8_WAIT_L(8); PG8_BAR; PG8_WAIT_L(0); PG8_MMA(0, 0, At, B0); PG8_BAR; PG8_SCHED;
            PG8_LDB(B1, 1, 1); PG8_STAGE(PG8_SB(1, 0), b3, voffB);
            PG8_BAR; PG8_WAIT_L(0); PG8_MMA(0, 1, At, B1); PG8_BAR;
            PG8_LDA(At, 1, 1); PG8_STAGE(PG8_SA(1, 0), a3, voffA);
            PG8_BAR; PG8_WAIT_L(0); PG8_MMA(1, 0, At, B0); PG8_BAR; PG8_SCHED;
            PG8_STAGE(PG8_SB(1, 1), b3 + hstep, voffB);
            PG8_WAIT_V(6); PG8_BAR; PG8_MMA(1, 1, At, B1); PG8_BAR;
            }
        }
        if constexpr (ALIGN_EPI) { if (wr == 0) PG8_BAR; }
        if constexpr (!Epi::AFTER_DRAIN) { E(acc, cur, wr, wc, fr, fq); S.done(cur); }
        if (!has_next) break;
#pragma unroll
        for (int a = 0; a < 2; ++a)
#pragma unroll
            for (int b = 0; b < 2; ++b)
#pragma unroll
                for (int m = 0; m < 4; ++m)
#pragma unroll
                    for (int n = 0; n < 2; ++n) acc[a][b][m][n] = (f32x4){0.f, 0.f, 0.f, 0.f};
        cur = nxt; cA = nA; cB = nB; ++ui;
        if constexpr (ALIGN_EPI) { if (wr == 1) PG8_BAR; }
    }
    PG8_WAIT_V(0);
    if constexpr (!ALIGN_EPI) { if (wr == 0) PG8_BAR; }
    PG8_BAR;
    if constexpr (Epi::AFTER_DRAIN) { E.fused(acc, cur, wr, wc, fr, fq, lds, wid, lane); S.done(cur); }
#undef PG8_SA
#undef PG8_SB
#undef PG8_STAGE
#undef PG8_LDA
#undef PG8_LDB
#undef PG8_MMA
#undef PG8_WAIT_V
#undef PG8_WAIT_L
#undef PG8_BAR
#undef PG8_SCHED
}
}
#define LAS __attribute__((address_space(3)))
typedef unsigned short bf16;
typedef unsigned u32x4 __attribute__((ext_vector_type(4)));
typedef float f32x4 __attribute__((ext_vector_type(4)));
constexpr int BATCH = 16, SEQ = 2048, DM = 1024, T = BATCH * SEQ, DEPTH = 2;
constexpr int IN_W = 2840, PROJ_LD = 3072, FFN = 2816, MEML = 256;
constexpr int CQ = 0, CKC = 512, CVC = 640, CKS = 768, CVS = 896, CKW = 1024, CVW = 1152, CCB = 1280, CCC = 1792, CCX = 2304, CGL = 2816;
constexpr float RMS_EPS = 1e-6f;
constexpr int NWAVES = 8, NTHREADS = 512;
constexpr int LDS_BYTES = 147456;
constexpr size_t MiB = 1u << 20;
constexpr size_t WS_W = 1 * MiB, W_LAYER = 27 * MiB;
constexpr size_t WO_IN = 0, WO_OUT = 6 * MiB, WO_Q = 8 * MiB, WO_KV = 8 * MiB + 512 * 1024, WO_O = 9 * MiB + 512 * 1024, WO_GU = 10 * MiB, WO_D = 21 * MiB;
constexpr size_t WS_MEMN = 56 * MiB, WS_MEMKV = 72 * MiB, WS_KCMP = 80 * MiB, WS_VCMP = 81 * MiB, WS_QM = 82 * MiB, WS_OM = 98 * MiB, WS_XB = 114 * MiB, WS_H = 178 * MiB, WS_PROJ = 306 * MiB, WS_END = 498 * MiB;

__device__ const int T5_BUCKET[128] = {0,1,2,3,4,5,6,7,8,9,10,11,12,13,14,15,16,16,16,17,17,18,18,18,19,19,19,20,20,20,20,21,21,21,21,22,22,22,22,22,23,23,23,23,23,23,24,24,24,24,24,24,25,25,25,25,25,25,25,26,26,26,26,26,26,26,26,27,27,27,27,27,27,27,27,27,27,28,28,28,28,28,28,28,28,28,28,29,29,29,29,29,29,29,29,29,29,29,29,30,30,30,30,30,30,30,30,30,30,30,30,30,30,31,31,31,31,31,31,31,31,31,31,31,31,31,31,31};

struct Params {
    const float *x, *mem, *rel_bias, *norms, *mem_norm, *gn_nsa, *gn_conv, *w_in, *w_out, *cmp_pe, *ck1, *ck2, *cv1, *cv2, *conv_w, *mem_wq, *mem_wkv, *mem_wo, *ffn_wg, *ffn_wu, *ffn_wd;
    float* out; unsigned char* ws; int ph_lo, ph_hi;
};

__device__ __forceinline__ unsigned f2bf(float f) { unsigned u = __builtin_bit_cast(unsigned, f); return (u + 0x7fffu + ((u >> 16) & 1u)) >> 16; }
__device__ __forceinline__ unsigned pk2(float lo, float hi) { return f2bf(lo) | (f2bf(hi) << 16); }
__device__ __forceinline__ float bflo(unsigned u) { return __uint_as_float(u << 16); }
__device__ __forceinline__ float bfhi(unsigned u) { return __uint_as_float(u & 0xffff0000u); }
__device__ __forceinline__ float wave_sum(float v) {
#pragma unroll
    for (int o = 1; o < 64; o <<= 1) v += __shfl_xor(v, o);
    return v;
}
#define LDS_WAIT() asm volatile("s_waitcnt lgkmcnt(0)" ::: "memory")
__device__ __forceinline__ int opaque_tid() { int t = __builtin_amdgcn_mbcnt_hi(~0u, __builtin_amdgcn_mbcnt_lo(~0u, 0u)); asm volatile("" : "+v"(t)); return t + 64 * __builtin_amdgcn_readfirstlane((int)(threadIdx.x >> 6)); }

__device__ __forceinline__ void transpose_item(const float* W, int N, bf16* WT, int ldk, int k0, int nsrc, int ndst, int nvalid, LAS float* scr, int lane) {
    const int n_ = lane & 31;
#pragma unroll 8
    for (int i = 0; i < 32; ++i) { const int kk = 2 * i + (lane >> 5); scr[kk * 33 + n_] = (n_ < nvalid) ? W[(size_t)(k0 + kk) * N + nsrc + n_] : 0.f; }
    LDS_WAIT(); asm volatile("" ::: "memory");
    const int c = lane & 7;
#pragma unroll
    for (int j = 0; j < 4; ++j) { const int n = (lane >> 3) + 8 * j; const LAS float* s = scr + (8 * c) * 33 + n;
        u32x4 o; o.x = pk2(s[0 * 33], s[1 * 33]); o.y = pk2(s[2 * 33], s[3 * 33]); o.z = pk2(s[4 * 33], s[5 * 33]); o.w = pk2(s[6 * 33], s[7 * 33]);
        *(u32x4*)(WT + (size_t)(ndst + n) * ldk + k0 + 8 * c) = o; }
    LDS_WAIT(); asm volatile("" ::: "memory");
}
__device__ __forceinline__ void weights_phase(const Params& p, LAS unsigned char* lds) {
    const int tid = opaque_tid(), lane = tid & 63, wave = __builtin_amdgcn_readfirstlane(tid >> 6), gw = blockIdx.x * NWAVES + wave, NGW = gridDim.x * NWAVES;
    LAS float* scr = (LAS float*)(lds + wave * 16384);
    constexpr int I_IN = 16 * 96, I_OUT = 16 * 32, I_Q = 16 * 8, I_KV = 16 * 16, I_O = 4 * 32, I_G = 16 * 88, I_D = 44 * 32;
    constexpr int PER_LAYER = I_IN + I_OUT + I_Q + I_KV + I_O + 2 * I_G + I_D;
    for (int it = gw; it < DEPTH * PER_LAYER; it += NGW) {
        const int l = it / PER_LAYER; int r = it % PER_LAYER;
        unsigned char* wl = p.ws + WS_W + (size_t)l * W_LAYER;
        if (r < I_IN) { const int kb = r / 96, db = r % 96, ndst = 32 * db; int nsrc, nv;
            if (ndst < 1280) { nsrc = ndst; nv = 32; } else if (ndst < 2816) { nsrc = ndst + 24; nv = 32; } else if (ndst == 2816) { nsrc = 1280; nv = 24; } else { nsrc = 0; nv = 0; }
            transpose_item(p.w_in + (size_t)l * DM * IN_W, IN_W, (bf16*)(wl + WO_IN), DM, 64 * kb, nsrc, ndst, nv, scr, lane); continue; } r -= I_IN;
        if (r < I_OUT) { const int kb = r / 32, nb = r % 32; transpose_item(p.w_out + (size_t)l * DM * DM, DM, (bf16*)(wl + WO_OUT), DM, 64 * kb, 32 * nb, 32 * nb, 32, scr, lane); continue; } r -= I_OUT;
        if (r < I_Q) { const int kb = r / 8, nb = r % 8; transpose_item(p.mem_wq + (size_t)l * DM * 256, 256, (bf16*)(wl + WO_Q), DM, 64 * kb, 32 * nb, 32 * nb, 32, scr, lane); continue; } r -= I_Q;
        if (r < I_KV) { const int kb = r / 16, nb = r % 16; transpose_item(p.mem_wkv + (size_t)l * DM * 512, 512, (bf16*)(wl + WO_KV), DM, 64 * kb, 32 * nb, 32 * nb, 32, scr, lane); continue; } r -= I_KV;
        if (r < I_O) { const int kb = r / 32, nb = r % 32; transpose_item(p.mem_wo + (size_t)l * 256 * DM, DM, (bf16*)(wl + WO_O), 256, 64 * kb, 32 * nb, 32 * nb, 32, scr, lane); continue; } r -= I_O;
        if (r < I_G) { const int kb = r / 88, nb = r % 88; transpose_item(p.ffn_wg + (size_t)l * DM * FFN, FFN, (bf16*)(wl + WO_GU), DM, 64 * kb, 32 * nb, 256 * (nb >> 2) + 32 * (nb & 3), 32, scr, lane); continue; } r -= I_G;
        if (r < I_G) { const int kb = r / 88, nb = r % 88; transpose_item(p.ffn_wu + (size_t)l * DM * FFN, FFN, (bf16*)(wl + WO_GU), DM, 64 * kb, 32 * nb, 256 * (nb >> 2) + 128 + 32 * (nb & 3), 32, scr, lane); continue; } r -= I_G;
        { const int kb = r / 32, nb = r % 32; transpose_item(p.ffn_wd + (size_t)l * FFN * DM, DM, (bf16*)(wl + WO_D), FFN, 64 * kb, 32 * nb, 32 * nb, 32, scr, lane); }
    }
}

template <bool RES, bool XBOUT>
__device__ __forceinline__ void row_pass(const float* xi, const float* h, const float* gpost, float* xo, const float* gpre, bf16* xb, int nrows) {
    const int tid = opaque_tid(), lane = tid & 63, wave = __builtin_amdgcn_readfirstlane(tid >> 6), gw = blockIdx.x * NWAVES + wave, NGW = gridDim.x * NWAVES;
    for (int m = gw; m < nrows; m += NGW) {
        const f32x4* xr = (const f32x4*)(xi + (size_t)m * DM) + lane;
        f32x4 v[4];
#pragma unroll
        for (int j = 0; j < 4; ++j) v[j] = xr[64 * j];
        if (RES) {
            const f32x4* hr = (const f32x4*)(h + (size_t)m * DM) + lane; f32x4 hv[4]; float s = 0.f;
#pragma unroll
            for (int j = 0; j < 4; ++j) { hv[j] = hr[64 * j]; s += (hv[j].x * hv[j].x + hv[j].y * hv[j].y) + (hv[j].z * hv[j].z + hv[j].w * hv[j].w); }
            const float r1 = rsqrtf(wave_sum(s) * (1.f / DM) + RMS_EPS);
            f32x4* xw = (f32x4*)(xo + (size_t)m * DM) + lane;
#pragma unroll
            for (int j = 0; j < 4; ++j) { const f32x4 g = ((const f32x4*)gpost)[lane + 64 * j]; v[j] = v[j] + hv[j] * r1 * g; xw[64 * j] = v[j]; }
        }
        if (XBOUT) {
            float s2 = 0.f;
#pragma unroll
            for (int j = 0; j < 4; ++j) s2 += (v[j].x * v[j].x + v[j].y * v[j].y) + (v[j].z * v[j].z + v[j].w * v[j].w);
            const float r2 = rsqrtf(wave_sum(s2) * (1.f / DM) + RMS_EPS);
            unsigned long long* o8 = (unsigned long long*)(xb + (size_t)m * DM) + lane;
#pragma unroll
            for (int j = 0; j < 4; ++j) { const f32x4 g = ((const f32x4*)gpre)[lane + 64 * j]; const f32x4 y = v[j] * r2 * g;
                o8[64 * j] = (unsigned long long)pk2(y.x, y.y) | ((unsigned long long)pk2(y.z, y.w) << 32); }
        }
    }
}

__device__ __forceinline__ float gelu_tanh(float x) { return 0.5f * x * (1.0f + tanhf(0.7978845608028654f * (x + 0.044715f * x * x * x))); }
__device__ __forceinline__ void compress_item(const Params& p, int l, int item, LAS unsigned char* lds) {
    const int tid = opaque_tid();
    const int b = item / 127, i = item % 127;
    LAS float* flat = (LAS float*)lds;
    LAS float* hid = flat + 4 * 2048;
    const bf16* proj = (const bf16*)(p.ws + WS_PROJ);
    const float* pe = p.cmp_pe + (size_t)l * 32 * 64;
    for (int e = tid; e < 4 * 2048; e += NTHREADS) { const int r = e >> 11, k = e & 2047, pp = k >> 6, d = k & 63, g = r & 1, kv = r >> 1;
        const bf16 v = proj[(size_t)(b * SEQ + 16 * i + pp) * PROJ_LD + (kv ? CVC : CKC) + g * 64 + d];
        flat[e] = __uint_as_float((unsigned)v << 16) + pe[pp * 64 + d]; }
    __syncthreads();
    { const int r = tid >> 7, j = tid & 127, kv = r >> 1;
      const float* w1 = (kv ? p.cv1 : p.ck1) + (size_t)l * 2048 * 128 + j; const LAS float* f = flat + r * 2048;
      float a0 = 0.f, a1 = 0.f, a2 = 0.f, a3 = 0.f;
#pragma unroll 2
      for (int k = 0; k < 2048; k += 4) { a0 += f[k] * w1[(size_t)k * 128]; a1 += f[k + 1] * w1[(size_t)(k + 1) * 128]; a2 += f[k + 2] * w1[(size_t)(k + 2) * 128]; a3 += f[k + 3] * w1[(size_t)(k + 3) * 128]; }
      hid[tid] = gelu_tanh((a0 + a1) + (a2 + a3)); }
    __syncthreads();
    if (tid < 256) { const int r = tid >> 6, e = tid & 63, g = r & 1, kv = r >> 1;
        const float* w2 = (kv ? p.cv2 : p.ck2) + (size_t)l * 128 * 64 + e; const LAS float* hh = hid + r * 128; float a = 0.f;
#pragma unroll 8
        for (int j = 0; j < 128; ++j) a += hh[j] * w2[j * 64];
        bf16* dst = (bf16*)(p.ws + (kv ? WS_VCMP : WS_KCMP)); dst[((size_t)(b * 2 + g) * 128 + i) * 64 + e] = (bf16)f2bf(a); }
    __syncthreads();
}

__device__ __forceinline__ void conv_part(const Params& p, int ly, int b, int ch, const bf16* proj, bf16* xb, int lane, int wave) {
    {
        const float* cw = p.conv_w + (size_t)ly * 3 * 512 + lane * 8; const float* gn = p.gn_conv + (size_t)ly * 512 + lane * 8;
        for (int tq = wave; tq < 64; tq += NWAVES) {
            const int t = 64 * ch + tq; const size_t row = (size_t)b * SEQ + t;
            float y[8];
#pragma unroll
            for (int e = 0; e < 8; ++e) y[e] = 0.f;
#pragma unroll
            for (int k = 0; k < 3; ++k) if (t - k >= 0) {
                const u32x4 cc = *(const u32x4*)(proj + (row - k) * PROJ_LD + CCC + lane * 8), cx = *(const u32x4*)(proj + (row - k) * PROJ_LD + CCX + lane * 8);
                const float* w = cw + k * 512;
                y[0] += w[0] * bflo(cc.x) * bflo(cx.x); y[1] += w[1] * bfhi(cc.x) * bfhi(cx.x); y[2] += w[2] * bflo(cc.y) * bflo(cx.y); y[3] += w[3] * bfhi(cc.y) * bfhi(cx.y);
                y[4] += w[4] * bflo(cc.z) * bflo(cx.z); y[5] += w[5] * bfhi(cc.z) * bfhi(cx.z); y[6] += w[6] * bflo(cc.w) * bflo(cx.w); y[7] += w[7] * bfhi(cc.w) * bfhi(cx.w); }
            const u32x4 cb = *(const u32x4*)(proj + row * PROJ_LD + CCB + lane * 8);
            y[0] *= bflo(cb.x); y[1] *= bfhi(cb.x); y[2] *= bflo(cb.y); y[3] *= bfhi(cb.y); y[4] *= bflo(cb.z); y[5] *= bfhi(cb.z); y[6] *= bflo(cb.w); y[7] *= bfhi(cb.w);
            float ss = 0.f;
#pragma unroll
            for (int e = 0; e < 8; ++e) ss += y[e] * y[e];
            const float r = rsqrtf(wave_sum(ss) * (1.f / 512.f) + RMS_EPS);
            u32x4 w; w.x = pk2(y[0] * r * gn[0], y[1] * r * gn[1]); w.y = pk2(y[2] * r * gn[2], y[3] * r * gn[3]); w.z = pk2(y[4] * r * gn[4], y[5] * r * gn[5]); w.w = pk2(y[6] * r * gn[6], y[7] * r * gn[7]);
            *(u32x4*)(xb + row * DM + 512 + lane * 8) = w;
        }
    }
}

struct Soft { float m, l; };
#define ATT_ROW_BF16(kptr, vptr, biasv) do { \
    const u32x4* kp_ = (const u32x4*)(kptr); float s_ = 0.f; \
    _Pragma("unroll") for (int c_ = 0; c_ < 8; ++c_) { const u32x4 kk_ = kp_[c_]; \
        s_ += q[8 * c_ + 0] * bflo(kk_.x) + q[8 * c_ + 1] * bfhi(kk_.x) + q[8 * c_ + 2] * bflo(kk_.y) + q[8 * c_ + 3] * bfhi(kk_.y) + q[8 * c_ + 4] * bflo(kk_.z) + q[8 * c_ + 5] * bfhi(kk_.z) + q[8 * c_ + 6] * bflo(kk_.w) + q[8 * c_ + 7] * bfhi(kk_.w); } \
    s_ = s_ * 0.125f + (biasv); \
    if (s_ > m) { const float f_ = __expf(m - s_); l *= f_; _Pragma("unroll") for (int d_ = 0; d_ < 64; ++d_) o[d_] *= f_; m = s_; } \
    const float p_ = __expf(s_ - m); l += p_; const u32x4* vp_ = (const u32x4*)(vptr); \
    _Pragma("unroll") for (int c_ = 0; c_ < 8; ++c_) { const u32x4 vv_ = vp_[c_]; \
        o[8 * c_ + 0] += p_ * bflo(vv_.x); o[8 * c_ + 1] += p_ * bfhi(vv_.x); o[8 * c_ + 2] += p_ * bflo(vv_.y); o[8 * c_ + 3] += p_ * bfhi(vv_.y); \
        o[8 * c_ + 4] += p_ * bflo(vv_.z); o[8 * c_ + 5] += p_ * bfhi(vv_.z); o[8 * c_ + 6] += p_ * bflo(vv_.w); o[8 * c_ + 7] += p_ * bfhi(vv_.w); } } while (0)

#ifdef NSA_NAIVE
__device__ __forceinline__ void nsa_item(const Params& p, int ly, int item, LAS unsigned char* lds) {
    const int tid = opaque_tid();
    const int b = item >> 5, ch = item & 31, lane = tid & 63, wave = __builtin_amdgcn_readfirstlane(tid >> 6);
    LAS float* PS = (LAS float*)lds;
    LAS float* IMP = PS + 64 * 2 * 128;
    LAS unsigned* SELM = (LAS unsigned*)(IMP + 64 * 2 * 32);
    LAS float* RB = (LAS float*)(SELM + 128);
    LAS int* BK = (LAS int*)(RB + 256);
    const bf16* proj = (const bf16*)(p.ws + WS_PROJ);
    bf16* xb = (bf16*)(p.ws + WS_XB);
    for (int e = tid; e < 64 * 2 * 128; e += NTHREADS) PS[e] = 0.f;
    if (tid < 256) RB[tid] = p.rel_bias[tid];
    if (tid < 128) BK[tid] = T5_BUCKET[tid];
    conv_part(p, ly, b, ch, proj, xb, lane, wave);
    __syncthreads();
    const int ql = tid >> 3, h = tid & 7, g = h >> 2, t = 64 * ch + ql; const size_t row = (size_t)b * SEQ + t;
    float q[64], o[64];
    float* outp = (float*)(p.ws + WS_H) + row * DM + h * 64;
    { const u32x4* qp = (const u32x4*)(proj + row * PROJ_LD + CQ + h * 64);
#pragma unroll
      for (int c = 0; c < 8; ++c) { const u32x4 v = qp[c]; q[8 * c] = bflo(v.x); q[8 * c + 1] = bfhi(v.x); q[8 * c + 2] = bflo(v.y); q[8 * c + 3] = bfhi(v.y); q[8 * c + 4] = bflo(v.z); q[8 * c + 5] = bfhi(v.z); q[8 * c + 6] = bflo(v.w); q[8 * c + 7] = bfhi(v.w); } }
    const bf16* gl = proj + row * PROJ_LD + CGL + h * 3;
    const float g0 = 1.f / (1.f + __expf(-__uint_as_float((unsigned)gl[0] << 16))), g1 = 1.f / (1.f + __expf(-__uint_as_float((unsigned)gl[1] << 16))), g2 = 1.f / (1.f + __expf(-__uint_as_float((unsigned)gl[2] << 16)));
    const LAS float* rb = RB + h * 32;
    {
        const int ncv = (t >= 31) ? ((t - 15) >> 4) : 0, nmax = 4 * ch + 3 > 127 ? 127 : 4 * ch + 3;
        const float* kc = (const float*)(p.ws + WS_KCMP) + ((size_t)b * 128 * 2 + g) * 64; const float* vc = (const float*)(p.ws + WS_VCMP) + ((size_t)b * 128 * 2 + g) * 64;
        float m = -1e30f, l = 0.f;
        for (int n = 0; n < ncv; ++n) { const f32x4* kp = (const f32x4*)(kc + (size_t)n * 128); float s = 0.f;
#pragma unroll
            for (int c = 0; c < 16; ++c) { const f32x4 kk = kp[c]; s += q[4 * c] * kk.x + q[4 * c + 1] * kk.y + q[4 * c + 2] * kk.z + q[4 * c + 3] * kk.w; }
            s = s * 0.125f + rb[BK[min(t - 16 * n - 31, 127)]];
            if (s > m) { l *= __expf(m - s); m = s; } l += __expf(s - m); }
        const float il = l > 0.f ? 1.f / l : 0.f;
#pragma unroll
        for (int d = 0; d < 64; ++d) o[d] = 0.f;
        for (int n = 0; n < nmax; ++n) { float pn = 0.f;
            if (n < ncv) { const f32x4* kp = (const f32x4*)(kc + (size_t)n * 128); float s = 0.f;
#pragma unroll
                for (int c = 0; c < 16; ++c) { const f32x4 kk = kp[c]; s += q[4 * c] * kk.x + q[4 * c + 1] * kk.y + q[4 * c + 2] * kk.z + q[4 * c + 3] * kk.w; }
                s = s * 0.125f + rb[BK[min(t - 16 * n - 31, 127)]];
                pn = __expf(s - m) * il;
                const f32x4* vp = (const f32x4*)(vc + (size_t)n * 128);
#pragma unroll
                for (int c = 0; c < 16; ++c) { const f32x4 vv = vp[c]; o[4 * c] += pn * vv.x; o[4 * c + 1] += pn * vv.y; o[4 * c + 2] += pn * vv.z; o[4 * c + 3] += pn * vv.w; } }
            float ps = pn; ps += __shfl_xor(ps, 1); ps += __shfl_xor(ps, 2);
            if ((h & 3) == 0) PS[(ql * 2 + g) * 128 + n] = ps; }
#pragma unroll
        for (int c = 0; c < 16; ++c) ((f32x4*)outp)[c] = (f32x4){g0 * o[4 * c], g0 * o[4 * c + 1], g0 * o[4 * c + 2], g0 * o[4 * c + 3]};
    }
    __syncthreads();
    for (int e = tid; e < 64 * 2 * 32; e += NTHREADS) { const int j = e & 31; const LAS float* ps = PS + (e >> 5) * 128 + 4 * j;
        IMP[e] = (j > 0 ? 0.5f * ps[-1] : 0.f) + ps[0] + ps[1] + ps[2] + 0.5f * ps[3]; }
    __syncthreads();
    if (tid < 128) { unsigned mask;
        if (ch < 8) mask = (1u << (ch + 1)) - 1u;
        else { mask = 1u | (1u << ch) | (1u << (ch - 1)); const LAS float* im = IMP + tid * 32;
            for (int r = 0; r < 5; ++r) { int best = 1; float bv = -1.f;
                for (int j = 1; j <= ch - 2; ++j) { const float v = im[j]; if (!((mask >> j) & 1u) && v > bv) { bv = v; best = j; } }
                mask |= 1u << best; } }
        SELM[tid] = mask; }
    __syncthreads();
    {
        unsigned mask = SELM[ql * 2 + g]; const int cnt = ch < 8 ? ch + 1 : 8;
        float m = -1e30f, l = 0.f;
#pragma unroll
        for (int d = 0; d < 64; ++d) o[d] = 0.f;
        for (int it = 0; it < cnt; ++it) { const int j = __builtin_ctz(mask); mask &= mask - 1u;
            const bf16* kb = proj + ((size_t)b * SEQ + 64 * j) * PROJ_LD + CKS + g * 64;
            for (int kk = 0; kk < 64; ++kk) { const int dist = t - (64 * j + kk);
                if (dist >= 0) ATT_ROW_BF16(kb + (size_t)kk * PROJ_LD, kb + (size_t)kk * PROJ_LD + (CVS - CKS), rb[BK[min(dist, 127)]]); } }
        const float w = g1 / l;
#pragma unroll
        for (int c = 0; c < 16; ++c) { f32x4 a = ((f32x4*)outp)[c]; a.x += w * o[4 * c]; a.y += w * o[4 * c + 1]; a.z += w * o[4 * c + 2]; a.w += w * o[4 * c + 3]; ((f32x4*)outp)[c] = a; }
    }
    {
        float m = -1e30f, l = 0.f;
#pragma unroll
        for (int d = 0; d < 64; ++d) o[d] = 0.f;
        for (int kk = 0; kk < 256; ++kk) { const int pos = t - 255 + kk;
            if (pos >= 0) { const bf16* kb = proj + ((size_t)b * SEQ + pos) * PROJ_LD + CKW + g * 64; ATT_ROW_BF16(kb, kb + (CVW - CKW), rb[BK[min(255 - kk, 127)]]); } }
        const float w = g2 / l;
#pragma unroll
        for (int c = 0; c < 16; ++c) { const f32x4 a = ((f32x4*)outp)[c]; o[4 * c] = a.x + w * o[4 * c]; o[4 * c + 1] = a.y + w * o[4 * c + 1]; o[4 * c + 2] = a.z + w * o[4 * c + 2]; o[4 * c + 3] = a.w + w * o[4 * c + 3]; }
    }
    { float ss = 0.f;
#pragma unroll
      for (int d = 0; d < 64; ++d) ss += o[d] * o[d];
      ss += __shfl_xor(ss, 1); ss += __shfl_xor(ss, 2); ss += __shfl_xor(ss, 4);
      const float r = rsqrtf(ss * (1.f / 512.f) + RMS_EPS); const float* gn = p.gn_nsa + (size_t)ly * 512 + h * 64;
      u32x4* dst = (u32x4*)(xb + row * DM + h * 64);
#pragma unroll
      for (int c = 0; c < 8; ++c) { u32x4 w; w.x = pk2(o[8 * c] * r * gn[8 * c], o[8 * c + 1] * r * gn[8 * c + 1]); w.y = pk2(o[8 * c + 2] * r * gn[8 * c + 2], o[8 * c + 3] * r * gn[8 * c + 3]);
          w.z = pk2(o[8 * c + 4] * r * gn[8 * c + 4], o[8 * c + 5] * r * gn[8 * c + 5]); w.w = pk2(o[8 * c + 6] * r * gn[8 * c + 6], o[8 * c + 7] * r * gn[8 * c + 7]); dst[c] = w; } }
    __syncthreads();
}

#endif

namespace nsa {
typedef short bf16x8 __attribute__((ext_vector_type(8)));
typedef float f32x16 __attribute__((ext_vector_type(16)));
typedef short s16x4 __attribute__((ext_vector_type(4)));
constexpr int KROWB = 144, KT_BYTES = 64 * KROWB, VT_BYTES = 8192;
constexpr int L_K = 0, L_V = 2 * KT_BYTES, L_TB = L_V + 2 * VT_BYTES, L_TBC = L_TB + 8 * 384 * 4, L_IMPA = L_TBC + 8 * 132 * 4, L_IMPB = L_IMPA + 8192, L_SELM = L_IMPB + 8192, L_END = L_SELM + 256;
constexpr float LOG2E = 1.4426950408889634f, QSCALE = 0.125f * LOG2E, NEG = -2e30f, MINIT = -1e30f;

__device__ __forceinline__ void build_tables(const float* rel_bias, LAS unsigned char* lds, int tid) {
    LAS float* TB = (LAS float*)(lds + L_TB); LAS float* TBC = (LAS float*)(lds + L_TBC);
    for (int e = tid; e < 8 * 384; e += NTHREADS) { const int h = e / 384, x = e % 384, dist = 319 - x; TB[e] = (dist < 0 || dist > 255) ? NEG : rel_bias[h * 32 + T5_BUCKET[dist > 127 ? 127 : dist]] * LOG2E; }
    for (int e = tid; e < 8 * 132; e += NTHREADS) { const int h = e / 132, idx = e % 132; TBC[e] = (idx == 0 || idx > 128) ? NEG : rel_bias[h * 32 + T5_BUCKET[idx - 1]] * LOG2E; }
    __syncthreads();
}
template <int CTRL> __device__ __forceinline__ float dppf(float x) { return __builtin_bit_cast(float, __builtin_amdgcn_update_dpp(0, __builtin_bit_cast(int, x), CTRL, 0xf, 0xf, true)); }
__device__ __forceinline__ float quad_sum(float x) { x += dppf<0xB1>(x); x += dppf<0x4E>(x); return x; }
__device__ __forceinline__ unsigned cvtpk(float lo, float hi) { unsigned r; asm volatile("v_cvt_pk_bf16_f32 %0, %1, %2" : "=v"(r) : "v"(lo), "v"(hi)); return r; }
__device__ __forceinline__ s16x4 tr_read(LAS const unsigned char* p) { typedef short v4i16_t __attribute__((ext_vector_type(4))); return __builtin_bit_cast(s16x4, __builtin_amdgcn_ds_read_tr16_b64_v4i16((LAS v4i16_t*)p)); }

struct TileSrc { const bf16* K; const bf16* V; int stride; };
__device__ __forceinline__ void qk_tile(f32x16& p0, f32x16& p1, LAS const unsigned char* kt, const bf16x8 (&qf)[4], int r32, int hi) {
    LAS const unsigned char* kb = kt + r32 * KROWB + hi * 16;
#pragma unroll
    for (int d0 = 0; d0 < 4; ++d0) {
        const bf16x8 a0 = *(LAS const bf16x8*)(kb + d0 * 32), a1 = *(LAS const bf16x8*)(kb + 32 * KROWB + d0 * 32);
        p0 = __builtin_amdgcn_mfma_f32_32x32x16_bf16(a0, qf[d0], p0, 0, 0, 0); p1 = __builtin_amdgcn_mfma_f32_32x32x16_bf16(a1, qf[d0], p1, 0, 0, 0); }
}
__device__ __forceinline__ void pv_tile(f32x16 (&o)[2], LAS const unsigned char* vt, const u32x4 (&pw)[4], int lane) {
    const int hi = lane >> 5, grp = (lane >> 4) & 1, i = lane & 15;
    LAS const unsigned char* vb = vt + (4 * hi + (i >> 2)) * 64 + (16 * grp + 4 * (i & 3)) * 2;
#pragma unroll
    for (int dblk = 0; dblk < 2; ++dblk)
#pragma unroll
        for (int s = 0; s < 4; ++s) {
            const s16x4 lo = tr_read(vb + dblk * 4096 + (16 * s) * 64), hi4 = tr_read(vb + dblk * 4096 + (16 * s + 8) * 64);
            const bf16x8 vf = (bf16x8){lo[0], lo[1], lo[2], lo[3], hi4[0], hi4[1], hi4[2], hi4[3]};
            o[dblk] = __builtin_amdgcn_mfma_f32_32x32x16_bf16(vf, __builtin_bit_cast(bf16x8, pw[s]), o[dblk], 0, 0, 0); }
}
__device__ __forceinline__ float vmax16(const f32x16& a, const f32x16& b) {
    float x = fmaxf(a[0], b[0]);
#pragma unroll
    for (int r = 1; r < 16; ++r) x = fmaxf(x, fmaxf(a[r], b[r]));
    return x;
}
__device__ __forceinline__ void pack_p(u32x4 (&pw)[4], const f32x16& p0, const f32x16& p1) {
    pw[0] = (u32x4){cvtpk(p0[0], p0[1]), cvtpk(p0[2], p0[3]), cvtpk(p0[4], p0[5]), cvtpk(p0[6], p0[7])};
    pw[1] = (u32x4){cvtpk(p0[8], p0[9]), cvtpk(p0[10], p0[11]), cvtpk(p0[12], p0[13]), cvtpk(p0[14], p0[15])};
    pw[2] = (u32x4){cvtpk(p1[0], p1[1]), cvtpk(p1[2], p1[3]), cvtpk(p1[4], p1[5]), cvtpk(p1[6], p1[7])};
    pw[3] = (u32x4){cvtpk(p1[8], p1[9]), cvtpk(p1[10], p1[11]), cvtpk(p1[12], p1[13]), cvtpk(p1[14], p1[15])};
}
template <bool LOOKUP>
__device__ __forceinline__ void soft_tile(f32x16& p0, f32x16& p1, LAS const float* tbp, float& m, float& l, f32x16 (&o)[2], u32x4 (&pw)[4]) {
    if (LOOKUP) {
#pragma unroll
        for (int r = 0; r < 16; ++r) { p0[r] += tbp[(r & 3) + 8 * (r >> 2)]; p1[r] += tbp[32 + (r & 3) + 8 * (r >> 2)]; }
    }
    float mx = vmax16(p0, p1); mx = fmaxf(mx, __shfl_xor(mx, 32));
    const float mn = fmaxf(m, mx), alpha = __builtin_amdgcn_exp2f(m - mn); m = mn;
    float rs = 0.f;
#pragma unroll
    for (int r = 0; r < 16; ++r) { p0[r] = __builtin_amdgcn_exp2f(p0[r] - mn); p1[r] = __builtin_amdgcn_exp2f(p1[r] - mn); rs += p0[r] + p1[r]; }
    l = l * alpha + rs;
#pragma unroll
    for (int r = 0; r < 16; ++r) { o[0][r] *= alpha; o[1][r] *= alpha; }
    pack_p(pw, p0, p1);
}

__device__ __forceinline__ void nsa_unit(const Params& p, int b, int c, int g, LAS unsigned char* lds, int tid) {
    const int lane = tid & 63, w = __builtin_amdgcn_readfirstlane(tid >> 6), r32 = lane & 31, hi = lane >> 5, qi = r32 >> 2, hh = r32 & 3, h = 4 * g + hh, ql = 8 * w + qi, t = 64 * c + ql;
    const size_t row = (size_t)b * SEQ + t;
    const bf16* proj = (const bf16*)(p.ws + WS_PROJ);
    const bf16* kcb = (const bf16*)(p.ws + WS_KCMP) + (size_t)(b * 2 + g) * 128 * 64; const bf16* vcb = (const bf16*)(p.ws + WS_VCMP) + (size_t)(b * 2 + g) * 128 * 64;
    const int skey = tid >> 3, sch = tid & 7;
    LAS unsigned char* kdst = lds + L_K + skey * KROWB + sch * 16; LAS unsigned char* vdst = lds + L_V + (sch >> 2) * 4096 + skey * 64 + (sch & 3) * 16;
    const int NT = 2 + (c + 1) + (c + 1 < 5 ? c + 1 : 5), w0 = c > 4 ? c - 4 : 0;
#define NSA_SRC(i, S_) do { if ((i) < 2) { S_.K = kcb + (size_t)(64 * (i)) * 64; S_.V = vcb + (size_t)(64 * (i)) * 64; S_.stride = 64; } \
        else if ((i) < 3 + c) { S_.K = proj + ((size_t)b * SEQ + 64 * ((i) - 2)) * PROJ_LD + CKS + 64 * g; S_.V = S_.K + (CVS - CKS); S_.stride = PROJ_LD; } \
        else { S_.K = proj + ((size_t)b * SEQ + 64 * (w0 + (i) - 3 - c)) * PROJ_LD + CKW + 64 * g; S_.V = S_.K + (CVW - CKW); S_.stride = PROJ_LD; } } while (0)
#define NSA_LOAD(i) do { TileSrc s_; NSA_SRC(i, s_); kreg = *(const u32x4*)(s_.K + (size_t)skey * s_.stride + sch * 8); vreg = *(const u32x4*)(s_.V + (size_t)skey * s_.stride + sch * 8); } while (0)
#define NSA_WRITE(buf) do { *(LAS u32x4*)(kdst + (buf) * KT_BYTES) = kreg; *(LAS u32x4*)(vdst + (buf) * VT_BYTES) = vreg; } while (0)
    u32x4 kreg, vreg;
    NSA_LOAD(0);
    bf16x8 qf[4];
#pragma unroll
    for (int d0 = 0; d0 < 4; ++d0) qf[d0] = *(const bf16x8*)(proj + row * PROJ_LD + CQ + h * 64 + 16 * d0 + 8 * hi);
    const bf16* gl = proj + row * PROJ_LD + CGL + h * 3;
    const float g0 = 1.f / (1.f + __expf(-__uint_as_float((unsigned)gl[0] << 16))), g1 = 1.f / (1.f + __expf(-__uint_as_float((unsigned)gl[1] << 16))), g2 = 1.f / (1.f + __expf(-__uint_as_float((unsigned)gl[2] << 16)));
    NSA_WRITE(0);
    __syncthreads();
    f32x16 o[2], out[2]; u32x4 pw[4];
    LAS const float* TBh = (LAS const float*)(lds + L_TB) + h * 384; LAS const float* TBCh = (LAS const float*)(lds + L_TBC) + h * 132;
    const float rb31 = TBCh[128];
    unsigned selm;
    {
        f32x16 pa0, pa1, pb0, pb1;
#pragma unroll
        for (int r = 0; r < 16; ++r) { pa0[r] = 0.f; pa1[r] = 0.f; pb0[r] = 0.f; pb1[r] = 0.f; }
        NSA_LOAD(1);
        qk_tile(pa0, pa1, lds + L_K, qf, r32, hi);
        NSA_WRITE(1);
        __syncthreads();
        NSA_LOAD(2);
        qk_tile(pb0, pb1, lds + L_K + KT_BYTES, qf, r32, hi);
        const int Dc = t - 31 - 64 * hi;
#pragma unroll
        for (int r = 0; r < 16; ++r) { const int nr = (r & 3) + 8 * (r >> 2);
            { const int d = Dc - 16 * nr; pa0[r] += TBCh[min(max(d, -1), 127) + 1]; }
            { const int d = Dc - 16 * (32 + nr); pa1[r] += TBCh[min(max(d, -1), 127) + 1]; }
            { const int d = Dc - 16 * (64 + nr); pb0[r] += TBCh[min(max(d, -1), 127) + 1]; }
            { const int d = Dc - 16 * (96 + nr); pb1[r] += TBCh[min(max(d, -1), 127) + 1]; } }
        float mx = fmaxf(vmax16(pa0, pa1), vmax16(pb0, pb1)); mx = fmaxf(mx, __shfl_xor(mx, 32)); mx = fmaxf(mx, MINIT);
        float rs = 0.f;
#pragma unroll
        for (int r = 0; r < 16; ++r) { pa0[r] = __builtin_amdgcn_exp2f(pa0[r] - mx); pa1[r] = __builtin_amdgcn_exp2f(pa1[r] - mx); pb0[r] = __builtin_amdgcn_exp2f(pb0[r] - mx); pb1[r] = __builtin_amdgcn_exp2f(pb1[r] - mx);
            rs += (pa0[r] + pa1[r]) + (pb0[r] + pb1[r]); }
        rs += __shfl_xor(rs, 32);
        const float il = rs > 0.f ? 1.f / rs : 0.f;
#pragma unroll
        for (int r = 0; r < 16; ++r) { pa0[r] *= il; pa1[r] *= il; pb0[r] *= il; pb1[r] *= il; }
        LAS float* IA = (LAS float*)(lds + L_IMPA) + w * 256 + qi * 32; LAS float* IB = (LAS float*)(lds + L_IMPB) + w * 256 + qi * 32;
#pragma unroll
        for (int k = 0; k < 4; ++k) {
            const float a0 = quad_sum((pa0[4 * k] + pa0[4 * k + 1]) + (pa0[4 * k + 2] + 0.5f * pa0[4 * k + 3])), b0 = quad_sum(0.5f * pa0[4 * k + 3]);
            const float a1 = quad_sum((pa1[4 * k] + pa1[4 * k + 1]) + (pa1[4 * k + 2] + 0.5f * pa1[4 * k + 3])), b1 = quad_sum(0.5f * pa1[4 * k + 3]);
            const float a2 = quad_sum((pb0[4 * k] + pb0[4 * k + 1]) + (pb0[4 * k + 2] + 0.5f * pb0[4 * k + 3])), b2 = quad_sum(0.5f * pb0[4 * k + 3]);
            const float a3 = quad_sum((pb1[4 * k] + pb1[4 * k + 1]) + (pb1[4 * k + 2] + 0.5f * pb1[4 * k + 3])), b3 = quad_sum(0.5f * pb1[4 * k + 3]);
            if (hh == 0) { const int j = 2 * k + hi; IA[j] = a0; IB[j] = b0; IA[8 + j] = a1; IB[8 + j] = b1; IA[16 + j] = a2; IB[16 + j] = b2; IA[24 + j] = a3; IB[24 + j] = b3; } }
        asm volatile("s_waitcnt lgkmcnt(0)" ::: "memory");
        if (lane < 8) { unsigned mask;
            if (c < 8) mask = (1u << (c + 1)) - 1u;
            else { mask = 1u | (1u << c) | (1u << (c - 1));
                LAS const float* A = (LAS const float*)(lds + L_IMPA) + w * 256 + lane * 32; LAS const float* B = (LAS const float*)(lds + L_IMPB) + w * 256 + lane * 32;
                for (int rr = 0; rr < 5; ++rr) { int best = 1; float bv = -1.f;
                    for (int j = 1; j <= c - 2; ++j) { const float v = A[j] + B[j - 1]; if (!((mask >> j) & 1u) && v > bv) { bv = v; best = j; } }
                    mask |= 1u << best; } }
            ((LAS unsigned*)(lds + L_SELM))[w * 8 + lane] = mask; }
        asm volatile("s_waitcnt lgkmcnt(0)" ::: "memory");
        selm = ((LAS const unsigned*)(lds + L_SELM))[w * 8 + qi];
#pragma unroll
        for (int r = 0; r < 16; ++r) { o[0][r] = 0.f; o[1][r] = 0.f; }
        pack_p(pw, pa0, pa1); pv_tile(o, lds + L_V, pw, lane);
        pack_p(pw, pb0, pb1); pv_tile(o, lds + L_V + VT_BYTES, pw, lane);
#pragma unroll
        for (int r = 0; r < 16; ++r) { out[0][r] = g0 * o[0][r]; out[1][r] = g0 * o[1][r]; o[0][r] = 0.f; o[1][r] = 0.f; }
        __syncthreads();
        NSA_WRITE(0);
        __syncthreads();
    }
    float m = MINIT, l = 0.f;
    for (int i = 2; i < NT; ++i) {
        const bool more = i + 1 < NT;
        if (more) NSA_LOAD(i + 1);
        const bool win = i >= 3 + c; const int j = win ? w0 + i - 3 - c : i - 2, dj = c - j;
        const bool lookup = dj <= 2 || (win && dj == 4);
        const bool on = win || ((selm >> j) & 1u);
        const float cb = lookup ? (on ? 0.f : NEG) : (on ? rb31 : NEG);
        f32x16 p0, p1;
#pragma unroll
        for (int r = 0; r < 16; ++r) { p0[r] = cb; p1[r] = cb; }
        LAS const unsigned char* kt = lds + L_K + (i & 1) * KT_BYTES; LAS const unsigned char* vt = lds + L_V + (i & 1) * VT_BYTES;
        qk_tile(p0, p1, kt, qf, r32, hi);
        if (lookup) soft_tile<true>(p0, p1, TBh + (319 - (64 * dj + ql) + 4 * hi), m, l, o, pw);
        else soft_tile<false>(p0, p1, TBh, m, l, o, pw);
        pv_tile(o, vt, pw, lane);
        if (i == 2 + c || i == NT - 1) {
            const float lt = l + __shfl_xor(l, 32), wgt = (win ? g2 : g1) / lt;
#pragma unroll
            for (int r = 0; r < 16; ++r) { out[0][r] += wgt * o[0][r]; out[1][r] += wgt * o[1][r]; o[0][r] = 0.f; o[1][r] = 0.f; }
            m = MINIT; l = 0.f; }
        if (more) NSA_WRITE((i + 1) & 1);
        __syncthreads();
    }
    float* outp = (float*)(p.ws + WS_H) + row * DM + h * 64 + 4 * hi;
#pragma unroll
    for (int dblk = 0; dblk < 2; ++dblk)
#pragma unroll
        for (int k = 0; k < 4; ++k) *(f32x4*)(outp + 32 * dblk + 8 * k) = (f32x4){out[dblk][4 * k], out[dblk][4 * k + 1], out[dblk][4 * k + 2], out[dblk][4 * k + 3]};
#undef NSA_SRC
#undef NSA_LOAD
#undef NSA_WRITE
}
}

__device__ __forceinline__ void nsa_item_mfma(const Params& p, int ly, int item, LAS unsigned char* lds) {
    const int tid = opaque_tid();
    const int b = item >> 5, ch = item & 31, lane = tid & 63, wave = __builtin_amdgcn_readfirstlane(tid >> 6);
    const bf16* proj = (const bf16*)(p.ws + WS_PROJ);
    bf16* xb = (bf16*)(p.ws + WS_XB);
    conv_part(p, ly, b, ch, proj, xb, lane, wave);
    nsa::nsa_unit(p, b, ch, 0, lds, tid);
    nsa::nsa_unit(p, b, ch, 1, lds, tid);
    __syncthreads();
    { const int ql = tid >> 3, h = tid & 7; const size_t row = (size_t)b * SEQ + 64 * ch + ql;
      const f32x4* src = (const f32x4*)((const float*)(p.ws + WS_H) + row * DM + h * 64); f32x4 v[16]; float ss = 0.f;
#pragma unroll
      for (int c = 0; c < 16; ++c) { v[c] = src[c]; ss += (v[c].x * v[c].x + v[c].y * v[c].y) + (v[c].z * v[c].z + v[c].w * v[c].w); }
      ss += __shfl_xor(ss, 1); ss += __shfl_xor(ss, 2); ss += __shfl_xor(ss, 4);
      const float r = rsqrtf(ss * (1.f / 512.f) + RMS_EPS); const f32x4* gn = (const f32x4*)(p.gn_nsa + (size_t)ly * 512 + h * 64);
      u32x4* dst = (u32x4*)(xb + row * DM + h * 64);
#pragma unroll
      for (int c = 0; c < 8; ++c) { const f32x4 a = v[2 * c] * r * gn[2 * c], bb = v[2 * c + 1] * r * gn[2 * c + 1]; u32x4 wv; wv.x = pk2(a.x, a.y); wv.y = pk2(a.z, a.w); wv.z = pk2(bb.x, bb.y); wv.w = pk2(bb.z, bb.w); dst[c] = wv; } }
    __syncthreads();
}

__device__ __forceinline__ void memattn_item(const Params& p, int ly, int item) {
    const int tid = opaque_tid();
    const int b = item >> 4, qt = item & 15, ql = tid >> 2, hm = tid & 3; const size_t row = (size_t)b * SEQ + 128 * qt + ql;
    const bf16* qm = (const bf16*)(p.ws + WS_QM); const bf16* kv = (const bf16*)(p.ws + WS_MEMKV) + (size_t)ly * 4096 * 512 + (size_t)b * MEML * 512 + hm * 64;
    float q[64], o[64];
    { const u32x4* qp = (const u32x4*)(qm + row * 256 + hm * 64);
#pragma unroll
      for (int c = 0; c < 8; ++c) { const u32x4 v = qp[c]; q[8 * c] = bflo(v.x); q[8 * c + 1] = bfhi(v.x); q[8 * c + 2] = bflo(v.y); q[8 * c + 3] = bfhi(v.y); q[8 * c + 4] = bflo(v.z); q[8 * c + 5] = bfhi(v.z); q[8 * c + 6] = bflo(v.w); q[8 * c + 7] = bfhi(v.w); } }
    float m = -1e30f, l = 0.f;
#pragma unroll
    for (int d = 0; d < 64; ++d) o[d] = 0.f;
    for (int k = 0; k < MEML; ++k) ATT_ROW_BF16(kv + (size_t)k * 512, kv + (size_t)k * 512 + 256, 0.f);
    const float il = 1.f / l;
    u32x4* dst = (u32x4*)((bf16*)(p.ws + WS_OM) + row * 256 + hm * 64);
#pragma unroll
    for (int c = 0; c < 8; ++c) { u32x4 w; w.x = pk2(o[8 * c] * il, o[8 * c + 1] * il); w.y = pk2(o[8 * c + 2] * il, o[8 * c + 3] * il); w.z = pk2(o[8 * c + 4] * il, o[8 * c + 5] * il); w.w = pk2(o[8 * c + 6] * il, o[8 * c + 7] * il); dst[c] = w; }
}

template <class Epi>
__device__ __forceinline__ void run_gemm(LAS unsigned char* lds, const bf16* A, const bf16* Bt, int M, int N, int K, const Epi& E) {
    pg8::Gemm g{A, Bt, M, N, K}; pg8::StaticOrder S; S.init(M, N, (int)gridDim.x, (int)blockIdx.x);
    pg8::gemm_phase<Epi, pg8::StaticOrder, true, true>(lds, g, S, E);
}

__global__ void __launch_bounds__(NTHREADS, 2) hymba_fwd(Params p) {
    extern __shared__ __attribute__((aligned(16))) unsigned char lds_raw[];
    LAS unsigned char* lds = (LAS unsigned char*)lds_raw;
    cg::grid_group grid = cg::this_grid();
    const int G = gridDim.x;
    unsigned char* ws = p.ws;
    bf16* XB = (bf16*)(ws + WS_XB); float* H = (float*)(ws + WS_H); bf16* PROJ = (bf16*)(ws + WS_PROJ); bf16* HID = PROJ;
    bf16* QM = (bf16*)(ws + WS_QM); bf16* OM = (bf16*)(ws + WS_OM); bf16* MEMN = (bf16*)(ws + WS_MEMN); bf16* MEMKV = (bf16*)(ws + WS_MEMKV);
    int ph = 0;
#define PHASE_BEGIN if (ph >= p.ph_lo && ph < p.ph_hi) {
#define PHASE_END   if (ph + 1 < p.ph_hi) grid.sync(); } ++ph;

    PHASE_BEGIN
        weights_phase(p, lds);
        row_pass<false, true>(p.x, nullptr, nullptr, nullptr, p.norms, XB, T);
        for (int l = 0; l < DEPTH; ++l) row_pass<false, true>(p.mem, nullptr, nullptr, nullptr, p.mem_norm + l * DM, MEMN + (size_t)l * 4096 * DM, BATCH * MEML);
        __syncthreads();
    PHASE_END

    for (int l = 0; l < DEPTH; ++l) {
        const unsigned char* wl = ws + WS_W + (size_t)l * W_LAYER;
        const float* nl = p.norms + (size_t)l * 6 * DM;
        const float* xin = (l == 0) ? p.x : p.out;
        PHASE_BEGIN
            run_gemm(lds, XB, (const bf16*)(wl + WO_IN), T, PROJ_LD, DM, pg8::EpiStoreBf16{PROJ, PROJ_LD, 2, nsa::QSCALE});
            run_gemm(lds, MEMN + (size_t)l * 4096 * DM, (const bf16*)(wl + WO_KV), BATCH * MEML, 512, DM, pg8::EpiStoreBf16{MEMKV + (size_t)l * 4096 * 512, 512, 0, 1.f});
        PHASE_END
        PHASE_BEGIN
            for (int it = blockIdx.x; it < BATCH * 127; it += G) compress_item(p, l, it, lds);
        PHASE_END
        PHASE_BEGIN
#ifdef NSA_NAIVE
            for (int it = blockIdx.x; it < BATCH * 32; it += G) nsa_item(p, l, (it & ~31) | (it < 256 ? 31 - (it & 31) : (it & 31)), lds);
#else
            nsa::build_tables(p.rel_bias, lds, opaque_tid());
            for (int it = blockIdx.x; it < BATCH * 32; it += G) nsa_item_mfma(p, l, (it & ~31) | (it < 256 ? 31 - (it & 31) : (it & 31)), lds);
#endif
        PHASE_END
        PHASE_BEGIN
            run_gemm(lds, XB, (const bf16*)(wl + WO_OUT), T, DM, DM, pg8::EpiStoreF32{H, DM});
        PHASE_END
        PHASE_BEGIN
            row_pass<true, true>(xin, H, nl + DM, p.out, nl + 2 * DM, XB, T);
        PHASE_END
        PHASE_BEGIN
            run_gemm(lds, XB, (const bf16*)(wl + WO_Q), T, 256, DM, pg8::EpiStoreBf16{QM, 256, 0, 1.f});
        PHASE_END
        PHASE_BEGIN
            for (int it = blockIdx.x; it < BATCH * 16; it += G) memattn_item(p, l, it);
        PHASE_END
        PHASE_BEGIN
            run_gemm(lds, OM, (const bf16*)(wl + WO_O), T, DM, 256, pg8::EpiStoreF32{H, DM});
        PHASE_END
        PHASE_BEGIN
            row_pass<true, true>(p.out, H, nl + 3 * DM, p.out, nl + 4 * DM, XB, T);
        PHASE_END
        PHASE_BEGIN
            run_gemm(lds, XB, (const bf16*)(wl + WO_GU), T, 2 * FFN, DM, pg8::EpiSwiGLU{HID, FFN});
        PHASE_END
        PHASE_BEGIN
            run_gemm(lds, HID, (const bf16*)(wl + WO_D), T, DM, FFN, pg8::EpiStoreF32{H, DM});
        PHASE_END
        PHASE_BEGIN
            if (l + 1 < DEPTH) row_pass<true, true>(p.out, H, nl + 5 * DM, p.out, nl + 6 * DM, XB, T);
            else row_pass<true, false>(p.out, H, nl + 5 * DM, p.out, nullptr, nullptr, T);
        PHASE_END
    }
}
constexpr int N_PHASES = 1 + DEPTH * 12;

extern "C" void kernel_launch(void* const* d_in, const int* in_sizes, int n_in, void* d_out, int out_size, void* d_ws, size_t ws_size, hipStream_t stream) {
    static int grid = 0;
    if (grid == 0) {
        if (n_in != 21 || in_sizes[0] != T * DM || out_size != T * DM || ws_size < WS_END) { fprintf(stderr, "kernel_launch: unexpected problem (n_in %d, in0 %d, out %d, ws %zu < %zu)\n", n_in, n_in > 0 ? in_sizes[0] : -1, out_size, ws_size, (size_t)WS_END); grid = -1; return; }
        int dev = 0, cus = 0, per_cu = 0;
        if (hipGetDevice(&dev) != hipSuccess || hipDeviceGetAttribute(&cus, hipDeviceAttributeMultiprocessorCount, dev) != hipSuccess) { grid = -1; return; }
        if (hipFuncSetAttribute((const void*)hymba_fwd, hipFuncAttributeMaxDynamicSharedMemorySize, LDS_BYTES) != hipSuccess) { fprintf(stderr, "kernel_launch: hipFuncSetAttribute failed\n"); grid = -1; return; }
        if (hipOccupancyMaxActiveBlocksPerMultiprocessor(&per_cu, (const void*)hymba_fwd, NTHREADS, LDS_BYTES) != hipSuccess || per_cu < 1) { fprintf(stderr, "kernel_launch: occupancy query says %d blocks per CU\n", per_cu); grid = -1; return; }
        grid = cus;
    }
    if (grid < 0) return;
    Params p{};
    const float** fp = (const float**)&p;
    for (int i = 0; i < 21; ++i) fp[i] = (const float*)d_in[i];
    p.out = (float*)d_out; p.ws = (unsigned char*)d_ws;
#ifndef N_LAUNCH_PER_PHASE
    p.ph_lo = 0; p.ph_hi = N_PHASES;
    { void* args[] = {&p};
      hipError_t e = hipLaunchCooperativeKernel((void*)hymba_fwd, dim3(grid), dim3(NTHREADS), args, LDS_BYTES, stream);
      if (e != hipSuccess) fprintf(stderr, "cooperative launch failed: %s (grid %d)\n", hipGetErrorString(e), grid); }
#else
    for (int ph = 0; ph < N_PHASES; ++ph) { p.ph_lo = ph; p.ph_hi = ph + 1; void* args[] = {&p};
      hipError_t e = hipLaunchCooperativeKernel((void*)hymba_fwd, dim3(grid), dim3(NTHREADS), args, LDS_BYTES, stream);
      if (e != hipSuccess) { fprintf(stderr, "cooperative launch failed: %s (grid %d)\n", hipGetErrorString(e), grid); break; } }
#endif
}
```

```cpp
#include <hip/hip_runtime.h>
#include <hip/hip_cooperative_groups.h>
#include <cstdio>
#include <cstdint>
namespace cg = cooperative_groups;
namespace pg8 {
#define PG8_LAS __attribute__((address_space(3)))
typedef unsigned short bf16_t;
typedef short bf16x8 __attribute__((ext_vector_type(8)));
typedef float f32x4 __attribute__((ext_vector_type(4)));
typedef unsigned u32x4 __attribute__((ext_vector_type(4)));
constexpr int BM = 256, BK = 64, HALF = 128, HTB = HALF * BK * 2  , STAGE_BYTES = 8 * HTB, NXCD = 8, WGM = 8;

__host__ __device__ __forceinline__ int lds_byte(int r, int c) { const int st = (r >> 4) * 2 + (c >> 5), rr = r & 15, cc = c & 31, ob = rr * 64 + cc * 2; return st * 1024 + (ob ^ (((ob >> 9) & 1) << 5)); }
__host__ __device__ __forceinline__ void stage_rc(int b, int& R, int& C) { const int st = b / 1024, sb = b % 1024, swz = sb ^ (((sb >> 9) & 1) << 5); R = (st >> 1) * 16 + swz / 64; C = (st & 1) * 32 + (swz % 64) / 2; }
__host__ __device__ __forceinline__ int perm32(int rho) { const int n = rho >> 4, i = rho & 15; return 8 * (i >> 2) + 4 * n + (i & 3); }

struct Unit { int pm, pn; };
struct Gemm { const bf16_t* A; const bf16_t* Bt; int M, N, K; };

struct StaticOrder {
    int nM, nN, nwg, G, c;
    __host__ __device__ void init(int M, int N, int G_, int c_) { nM = M / BM; nN = N / BM; nwg = nM * nN; G = G_; c = c_; }
    __host__ __device__ bool next(int i, Unit& u) const {
        const long L = (long)i * G + c; if (L >= nwg) return false;
        int wgid = (int)L; { const int q = nwg / NXCD, r = nwg % NXCD, xcd = wgid % NXCD, off = wgid / NXCD; wgid = (xcd < r ? xcd * (q + 1) : r * (q + 1) + (xcd - r) * q) + off; }
        const int nig = WGM * nN, gid = wgid / nig, fm = gid * WGM, gsz = (nM - fm) < WGM ? (nM - fm) : WGM;
        u.pm = fm + ((wgid % nig) % gsz); u.pn = (wgid % nig) / gsz; return true;
    }
    __device__ __forceinline__ void a_ready(const Unit&) const {}
    __device__ __forceinline__ void done(const Unit&) const {}
};

__device__ __forceinline__ unsigned cvt_pk_bf16(float lo, float hi) { unsigned r; asm volatile("v_cvt_pk_bf16_f32 %0, %1, %2" : "=v"(r) : "v"(lo), "v"(hi)); return r; }
typedef float f32x2 __attribute__((ext_vector_type(2)));
struct EpiStoreBf16 {
    static constexpr bool PERM = true, AFTER_DRAIN = false;
    bf16_t* O; int ldc; int scale_tiles; float scale;
    __device__ __forceinline__ void operator()(const f32x4 (&acc)[2][2][4][2], const Unit& u, int wr, int wc, int fr, int fq) const {
        const int row0 = u.pm * BM + wr * 64 + fr, col0 = u.pn * BM + wc * 32 + 8 * fq; const float sc = u.pn < scale_tiles ? scale : 1.f;
#pragma unroll
        for (int ai = 0; ai < 2; ++ai)
#pragma unroll
            for (int m = 0; m < 4; ++m) { bf16_t* rowp = O + (size_t)(row0 + ai * HALF + m * 16) * ldc + col0;
#pragma unroll
                for (int bj = 0; bj < 2; ++bj) { const f32x4 v0 = acc[ai][bj][m][0] * sc, v1 = acc[ai][bj][m][1] * sc;
                    u32x4 w; w.x = cvt_pk_bf16(v0[0], v0[1]); w.y = cvt_pk_bf16(v0[2], v0[3]); w.z = cvt_pk_bf16(v1[0], v1[1]); w.w = cvt_pk_bf16(v1[2], v1[3]);
                    *(u32x4*)(rowp + bj * HALF) = w; } }
    }
};
struct EpiStoreF32 {
    static constexpr bool PERM = true, AFTER_DRAIN = false;
    float* O; int ldc;
    __device__ __forceinline__ void operator()(const f32x4 (&acc)[2][2][4][2], const Unit& u, int wr, int wc, int fr, int fq) const {
        const int row0 = u.pm * BM + wr * 64 + fr, col0 = u.pn * BM + wc * 32 + 8 * fq;
#pragma unroll
        for (int ai = 0; ai < 2; ++ai)
#pragma unroll
            for (int m = 0; m < 4; ++m) { float* rowp = O + (size_t)(row0 + ai * HALF + m * 16) * ldc + col0;
#pragma unroll
                for (int bj = 0; bj < 2; ++bj) { *(f32x4*)(rowp + bj * HALF) = acc[ai][bj][m][0]; *(f32x4*)(rowp + bj * HALF + 4) = acc[ai][bj][m][1]; } }
    }
};
struct EpiSwiGLU {
    static constexpr bool PERM = true, AFTER_DRAIN = false;
    bf16_t* O; int ldc;
    __device__ __forceinline__ void operator()(const f32x4 (&acc)[2][2][4][2], const Unit& u, int wr, int wc, int fr, int fq) const {
        const int row0 = u.pm * BM + wr * 64 + fr, col0 = u.pn * HALF + wc * 32 + 8 * fq;
#pragma unroll
        for (int ai = 0; ai < 2; ++ai)
#pragma unroll
            for (int m = 0; m < 4; ++m) { bf16_t* rowp = O + (size_t)(row0 + ai * HALF + m * 16) * ldc + col0;
                float h[8];
#pragma unroll
                for (int n = 0; n < 2; ++n)
#pragma unroll
                    for (int i = 0; i < 4; ++i) { const float g = acc[ai][0][m][n][i], up = acc[ai][1][m][n][i]; h[4 * n + i] = g * up / (1.0f + __expf(-g)); }
                u32x4 w; w.x = cvt_pk_bf16(h[0], h[1]); w.y = cvt_pk_bf16(h[2], h[3]); w.z = cvt_pk_bf16(h[4], h[5]); w.w = cvt_pk_bf16(h[6], h[7]);
                *(u32x4*)rowp = w; }
    }
};
template <class Epi, class Sched, bool ALIGN_EPI = false, bool SP2 = false>
__device__ __forceinline__ void gemm_phase(PG8_LAS unsigned char* lds, const Gemm g, const Sched& S, const Epi& E) {
    int tid_raw = __builtin_amdgcn_mbcnt_hi(~0u, __builtin_amdgcn_mbcnt_lo(~0u, 0u)); asm volatile("" : "+v"(tid_raw)); tid_raw += 64 * __builtin_amdgcn_readfirstlane((int)(threadIdx.x >> 6));
    const int tid = tid_raw, wid = __builtin_amdgcn_readfirstlane(tid >> 6), lane = tid & 63, wr = wid >> 2, wc = wid & 3, fr = lane & 15, fq = lane >> 4;
    const int K = g.K, nt = K / BK;
    unsigned voffA[2], voffB[2];
#pragma unroll
    for (int i = 0; i < 2; ++i) { int R, C; stage_rc(tid * 16 + i * 8192, R, C); const int Rb = Epi::PERM ? ((R & ~31) + perm32(R & 31)) : R;
        voffA[i] = (unsigned)(R * K + C) * 2u; voffB[i] = (unsigned)(Rb * K + C) * 2u; }
    const size_t kstep = (size_t)(BK * 2);
    const size_t hstep = (size_t)HALF * K * 2;
    const size_t tstep = 2 * hstep;
    const unsigned ldsw = (unsigned)wid * 1024u;
    const int aoff = lds_byte(wr * 64 + fr, fq * 8), boff = lds_byte(wc * 32 + fr, fq * 8);
#define PG8_SA(b, h) (((b) * 2 + (h)) * HTB)
#define PG8_SB(b, h) ((4 + (b) * 2 + (h)) * HTB)
#define PG8_STAGE(bufoff, gbase, voff) do { _Pragma("unroll") for (int _i = 0; _i < 2; ++_i) \
        __builtin_amdgcn_global_load_lds((const unsigned*)((const char*)(gbase) + (voff)[_i]), (PG8_LAS unsigned*)(lds + (bufoff) + ldsw + _i * 8192), 16, 0, 0); } while (0)
#define PG8_LDA(dst, b, h) do { _Pragma("unroll") for (int m = 0; m < 4; ++m) _Pragma("unroll") for (int k = 0; k < 2; ++k) dst[m][k] = *(const PG8_LAS bf16x8*)(lds + PG8_SA(b, h) + aoff + m * 2048 + k * 1024); } while (0)
#define PG8_LDB(dst, b, h) do { _Pragma("unroll") for (int n = 0; n < 2; ++n) _Pragma("unroll") for (int k = 0; k < 2; ++k) dst[n][k] = *(const PG8_LAS bf16x8*)(lds + PG8_SB(b, h) + boff + n * 2048 + k * 1024); } while (0)
#define PG8_MMA(ai, bj, At, Bt) do { __builtin_amdgcn_s_setprio(1); _Pragma("unroll") for (int m = 0; m < 4; ++m) _Pragma("unroll") for (int n = 0; n < 2; ++n) _Pragma("unroll") for (int k = 0; k < 2; ++k) \
        acc[ai][bj][m][n] = __builtin_amdgcn_mfma_f32_16x16x32_bf16(Bt[n][k], At[m][k], acc[ai][bj][m][n], 0, 0, 0); __builtin_amdgcn_s_setprio(0); } while (0)
#define PG8_WAIT_V(n) asm volatile("s_waitcnt vmcnt(" #n ")" ::: "memory")
#define PG8_WAIT_L(n) asm volatile("s_waitcnt lgkmcnt(" #n ")" ::: "memory")
#define PG8_BAR __builtin_amdgcn_s_barrier()
#define PG8_SCHED __builtin_amdgcn_sched_barrier(0)
    Unit cur, nxt; int ui = 0;
    if (!S.next(0, cur)) return;
    f32x4 acc[2][2][4][2];
#pragma unroll
    for (int a = 0; a < 2; ++a)
#pragma unroll
        for (int b = 0; b < 2; ++b)
#pragma unroll
            for (int m = 0; m < 4; ++m)
#pragma unroll
                for (int n = 0; n < 2; ++n) acc[a][b][m][n] = (f32x4){0.f, 0.f, 0.f, 0.f};
    bf16x8 At[4][2], B0[2][2], B1[2][2];
    const char* cA = (const char*)g.A + (size_t)cur.pm * tstep; const char* cB = (const char*)g.Bt + (size_t)cur.pn * tstep;
    S.a_ready(cur);
    if constexpr (SP2) {
        PG8_STAGE(PG8_SB(0, 0), cB, voffB); PG8_STAGE(PG8_SB(0, 1), cB + hstep, voffB); PG8_STAGE(PG8_SA(0, 0), cA, voffA); PG8_STAGE(PG8_SA(0, 1), cA + hstep, voffA);
        if (wr == 1) PG8_BAR;
        PG8_WAIT_V(2); PG8_BAR;
        PG8_STAGE(PG8_SB(1, 0), cB + kstep, voffB); PG8_STAGE(PG8_SA(1, 0), cA + kstep, voffA); PG8_STAGE(PG8_SB(1, 1), cB + hstep + kstep, voffB);
        PG8_WAIT_V(6); PG8_BAR;
    } else {
        PG8_STAGE(PG8_SB(0, 0), cB, voffB); PG8_STAGE(PG8_SA(0, 0), cA, voffA); PG8_STAGE(PG8_SB(0, 1), cB + hstep, voffB); PG8_STAGE(PG8_SA(0, 1), cA + hstep, voffA);
        if (wr == 1) PG8_BAR;
        PG8_WAIT_V(4); PG8_BAR;
        PG8_STAGE(PG8_SB(1, 0), cB + kstep, voffB); PG8_STAGE(PG8_SA(1, 0), cA + kstep, voffA); PG8_STAGE(PG8_SB(1, 1), cB + hstep + kstep, voffB);
        PG8_WAIT_V(6); PG8_BAR;
    }
    for (;;) {
        const bool has_next = S.next(ui + 1, nxt);
        const char* nA = has_next ? (const char*)g.A + (size_t)nxt.pm * tstep : cA; const char* nB = has_next ? (const char*)g.Bt + (size_t)nxt.pn * tstep : cB;
        for (int t = 0; t < nt; t += 2) {
            const bool last = (t == nt - 2);
            const char* a1 = cA + (size_t)(t + 1) * kstep;
            const char* a2 = last ? nA : cA + (size_t)(t + 2) * kstep; const char* b2 = last ? nB : cB + (size_t)(t + 2) * kstep;
            const char* a3 = a2 + kstep; const char* b3 = b2 + kstep;
            if (last && has_next) S.a_ready(nxt);
            if constexpr (SP2) {
            PG8_LDB(B0, 0, 0); PG8_LDB(B1, 0, 1); PG8_SCHED; PG8_LDA(At, 0, 0); PG8_STAGE(PG8_SA(1, 1), a1 + hstep, voffA);
            PG8_WAIT_V(8); PG8_WAIT_L(0); PG8_BAR; PG8_MMA(0, 0, At, B0); PG8_MMA(0, 1, At, B1); PG8_BAR; PG8_SCHED;
            PG8_LDA(At, 0, 1); PG8_STAGE(PG8_SB(0, 0), b2, voffB); PG8_STAGE(PG8_SB(0, 1), b2 + hstep, voffB); PG8_STAGE(PG8_SA(0, 0), a2, voffA);
            PG8_WAIT_V(8); PG8_WAIT_L(0); PG8_BAR; PG8_MMA(1, 0, At, B0); PG8_MMA(1, 1, At, B1); PG8_BAR; PG8_SCHED;
            PG8_LDB(B0, 1, 0); PG8_LDB(B1, 1, 1); PG8_SCHED; PG8_LDA(At, 1, 0); PG8_STAGE(PG8_SA(0, 1), a2 + hstep, voffA);
            PG8_WAIT_V(8); PG8_WAIT_L(0); PG8_BAR; PG8_MMA(0, 0, At, B0); PG8_MMA(0, 1, At, B1); PG8_BAR; PG8_SCHED;
            PG8_LDA(At, 1, 1); PG8_STAGE(PG8_SB(1, 0), b3, voffB); PG8_STAGE(PG8_SB(1, 1), b3 + hstep, voffB); PG8_STAGE(PG8_SA(1, 0), a3, voffA);
            PG8_WAIT_V(8); PG8_WAIT_L(0); PG8_BAR; PG8_MMA(1, 0, At, B0); PG8_MMA(1, 1, At, B1); PG8_BAR; PG8_SCHED;
            } else {
            PG8_LDB(B0, 0, 0); PG8_SCHED; PG8_LDA(At, 0, 0); PG8_STAGE(PG8_SA(1, 1), a1 + hstep, voffA);
            PG8_WAIT_L(8); PG8_BAR; PG8_WAIT_L(0); PG8_MMA(0, 0, At, B0); PG8_BAR; PG8_SCHED;
            PG8_LDB(B1, 0, 1); PG8_STAGE(PG8_SB(0, 0), b2, voffB);
            PG8_BAR; PG8_WAIT_L(0); PG8_MMA(0, 1, At, B1); PG8_BAR;
            PG8_LDA(At, 0, 1); PG8_STAGE(PG8_SA(0, 0), a2, voffA);
            PG8_BAR; PG8_WAIT_L(0); PG8_MMA(1, 0, At, B0); PG8_BAR; PG8_SCHED;
            PG8_STAGE(PG8_SB(0, 1), b2 + hstep, voffB);
            PG8_WAIT_V(6); PG8_BAR; PG8_MMA(1, 1, At, B1); PG8_BAR;
            PG8_LDB(B0, 1, 0); PG8_SCHED; PG8_LDA(At, 1, 0); PG8_STAGE(PG8_SA(0, 1), a2 + hstep, voffA);
            PG8_WAIT_L(8); PG8_BAR; PG8_WAIT_L(0); PG8_MMA(0, 0, At, B0); PG8_BAR; PG8_SCHED;
            PG8_LDB(B1, 1, 1); PG8_STAGE(PG8_SB(1, 0), b3, voffB);
            PG8_BAR; PG8_WAIT_L(0); PG8_MMA(0, 1, At, B1); PG8_BAR;
            PG8_LDA(At, 1, 1); PG8_STAGE(PG8_SA(1, 0), a3, voffA);
            PG8_BAR; PG8_WAIT_L(0); PG8_MMA(1, 0, At, B0); PG8_BAR; PG8_SCHED;
            PG8_STAGE(PG8_SB(1, 1), b3 + hstep, voffB);
            PG8_WAIT_V(6); PG8_BAR; PG8_MMA(1, 1, At, B1); PG8_BAR;
            }
        }
        if constexpr (ALIGN_EPI) { if (wr == 0) PG8_BAR; }
        if constexpr (!Epi::AFTER_DRAIN) { E(acc, cur, wr, wc, fr, fq); S.done(cur); }
        if (!has_next) break;
#pragma unroll
        for (int a = 0; a < 2; ++a)
#pragma unroll
            for (int b = 0; b < 2; ++b)
#pragma unroll
                for (int m = 0; m < 4; ++m)
#pragma unroll
                    for (int n = 0; n < 2; ++n) acc[a][b][m][n] = (f32x4){0.f, 0.f, 0.f, 0.f};
        cur = nxt; cA = nA; cB = nB; ++ui;
        if constexpr (ALIGN_EPI) { if (wr == 1) PG8_BAR; }
    }
    PG8_WAIT_V(0);
    if constexpr (!ALIGN_EPI) { if (wr == 0) PG8_BAR; }
    PG8_BAR;
    if constexpr (Epi::AFTER_DRAIN) { E.fused(acc, cur, wr, wc, fr, fq, lds, wid, lane); S.done(cur); }
#undef PG8_SA
#undef PG8_SB
#undef PG8_STAGE
#undef PG8_LDA
#undef PG8_LDB
#undef PG8_MMA
#undef PG8_WAIT_V
#undef PG8_WAIT_L
#undef PG8_BAR
#undef PG8_SCHED
}
}
#define LAS __attribute__((address_space(3)))
typedef unsigned short bf16;
typedef unsigned u32x4 __attribute__((ext_vector_type(4)));
typedef float f32x4 __attribute__((ext_vector_type(4)));
constexpr int BATCH = 16, SEQ = 2048, DM = 1024, T = BATCH * SEQ, DEPTH = 2;
constexpr int IN_W = 2840, PROJ_LD = 3072, FFN = 2816, MEML = 256;
constexpr int CQ = 0, CKC = 512, CVC = 640, CKS = 768, CVS = 896, CKW = 1024, CVW = 1152, CCB = 1280, CCC = 1792, CCX = 2304, CGL = 2816;
constexpr float RMS_EPS = 1e-6f;
constexpr int NWAVES = 8, NTHREADS = 512;
constexpr int LDS_BYTES = 147456, MISC_OFF = 131072 + 320;
constexpr int N_PHASES = 1 + 2 * 12;
constexpr size_t WS_CTL = 0; constexpr int CW_BAR = 4096, CTL_ZERO_BYTES = 65536;
constexpr size_t MiB = 1u << 20;
constexpr size_t WS_W = 1 * MiB, W_LAYER = 27 * MiB;
constexpr size_t WO_IN = 0, WO_OUT = 6 * MiB, WO_Q = 8 * MiB, WO_KV = 8 * MiB + 512 * 1024, WO_O = 9 * MiB + 512 * 1024, WO_GU = 10 * MiB, WO_D = 21 * MiB;
constexpr size_t WS_MEMN = 56 * MiB, WS_MEMKV = 72 * MiB, WS_KCMP = 80 * MiB, WS_VCMP = 81 * MiB, WS_QM = 82 * MiB, WS_OM = 98 * MiB, WS_XB = 114 * MiB, WS_H = 178 * MiB, WS_PROJ = 306 * MiB, WS_END = 498 * MiB;

__device__ const int T5_BUCKET[128] = {0,1,2,3,4,5,6,7,8,9,10,11,12,13,14,15,16,16,16,17,17,18,18,18,19,19,19,20,20,20,20,21,21,21,21,22,22,22,22,22,23,23,23,23,23,23,24,24,24,24,24,24,25,25,25,25,25,25,25,26,26,26,26,26,26,26,26,27,27,27,27,27,27,27,27,27,27,28,28,28,28,28,28,28,28,28,28,29,29,29,29,29,29,29,29,29,29,29,29,30,30,30,30,30,30,30,30,30,30,30,30,30,30,31,31,31,31,31,31,31,31,31,31,31,31,31,31,31};

struct Params {
    const float *x, *mem, *rel_bias, *norms, *mem_norm, *gn_nsa, *gn_conv, *w_in, *w_out, *cmp_pe, *ck1, *ck2, *cv1, *cv2, *conv_w, *mem_wq, *mem_wkv, *mem_wo, *ffn_wg, *ffn_wu, *ffn_wd;
    float* out; unsigned char* ws;
};

__device__ __forceinline__ unsigned f2bf(float f) { unsigned u = __builtin_bit_cast(unsigned, f); return (u + 0x7fffu + ((u >> 16) & 1u)) >> 16; }
__device__ __forceinline__ unsigned pk2(float lo, float hi) { return f2bf(lo) | (f2bf(hi) << 16); }
__device__ __forceinline__ float bflo(unsigned u) { return __uint_as_float(u << 16); }
__device__ __forceinline__ float bfhi(unsigned u) { return __uint_as_float(u & 0xffff0000u); }
__device__ __forceinline__ float wave_sum(float v) {
#pragma unroll
    for (int o = 1; o < 64; o <<= 1) v += __shfl_xor(v, o);
    return v;
}
#define LDS_WAIT() asm volatile("s_waitcnt lgkmcnt(0)" ::: "memory")
__device__ __forceinline__ int opaque_tid() { int t = __builtin_amdgcn_mbcnt_hi(~0u, __builtin_amdgcn_mbcnt_lo(~0u, 0u)); asm volatile("" : "+v"(t)); return t + 64 * __builtin_amdgcn_readfirstlane((int)(threadIdx.x >> 6)); }

__device__ __forceinline__ void transpose_item(const float* W, int N, bf16* WT, int ldk, int k0, int nsrc, int ndst, int nvalid, LAS float* scr, int lane) {
    const int n_ = lane & 31;
#pragma unroll 8
    for (int i = 0; i < 32; ++i) { const int kk = 2 * i + (lane >> 5); scr[kk * 33 + n_] = (n_ < nvalid) ? W[(size_t)(k0 + kk) * N + nsrc + n_] : 0.f; }
    LDS_WAIT(); asm volatile("" ::: "memory");
    const int c = lane & 7;
#pragma unroll
    for (int j = 0; j < 4; ++j) { const int n = (lane >> 3) + 8 * j; const LAS float* s = scr + (8 * c) * 33 + n;
        u32x4 o; o.x = pk2(s[0 * 33], s[1 * 33]); o.y = pk2(s[2 * 33], s[3 * 33]); o.z = pk2(s[4 * 33], s[5 * 33]); o.w = pk2(s[6 * 33], s[7 * 33]);
        *(u32x4*)(WT + (size_t)(ndst + n) * ldk + k0 + 8 * c) = o; }
    LDS_WAIT(); asm volatile("" ::: "memory");
}
__device__ __forceinline__ void weights_phase(const Params& p, LAS unsigned char* lds) {
    const int tid = opaque_tid(), lane = tid & 63, wave = __builtin_amdgcn_readfirstlane(tid >> 6), gw = blockIdx.x * NWAVES + wave, NGW = gridDim.x * NWAVES;
    LAS float* scr = (LAS float*)(lds + wave * 16384);
    constexpr int I_IN = 16 * 96, I_OUT = 16 * 32, I_Q = 16 * 8, I_KV = 16 * 16, I_O = 4 * 32, I_G = 16 * 88, I_D = 44 * 32;
    constexpr int PER_LAYER = I_IN + I_OUT + I_Q + I_KV + I_O + 2 * I_G + I_D;
    for (int it = gw; it < DEPTH * PER_LAYER; it += NGW) {
        const int l = it / PER_LAYER; int r = it % PER_LAYER;
        unsigned char* wl = p.ws + WS_W + (size_t)l * W_LAYER;
        if (r < I_IN) { const int kb = r / 96, db = r % 96, ndst = 32 * db; int nsrc, nv;
            if (ndst < 1280) { nsrc = ndst; nv = 32; } else if (ndst < 2816) { nsrc = ndst + 24; nv = 32; } else if (ndst == 2816) { nsrc = 1280; nv = 24; } else { nsrc = 0; nv = 0; }
            transpose_item(p.w_in + (size_t)l * DM * IN_W, IN_W, (bf16*)(wl + WO_IN), DM, 64 * kb, nsrc, ndst, nv, scr, lane); continue; } r -= I_IN;
        if (r < I_OUT) { const int kb = r / 32, nb = r % 32; transpose_item(p.w_out + (size_t)l * DM * DM, DM, (bf16*)(wl + WO_OUT), DM, 64 * kb, 32 * nb, 32 * nb, 32, scr, lane); continue; } r -= I_OUT;
        if (r < I_Q) { const int kb = r / 8, nb = r % 8; transpose_item(p.mem_wq + (size_t)l * DM * 256, 256, (bf16*)(wl + WO_Q), DM, 64 * kb, 32 * nb, 32 * nb, 32, scr, lane); continue; } r -= I_Q;
        if (r < I_KV) { const int kb = r / 16, nb = r % 16; transpose_item(p.mem_wkv + (size_t)l * DM * 512, 512, (bf16*)(wl + WO_KV), DM, 64 * kb, 32 * nb, 32 * nb, 32, scr, lane); continue; } r -= I_KV;
        if (r < I_O) { const int kb = r / 32, nb = r % 32; transpose_item(p.mem_wo + (size_t)l * 256 * DM, DM, (bf16*)(wl + WO_O), 256, 64 * kb, 32 * nb, 32 * nb, 32, scr, lane); continue; } r -= I_O;
        if (r < I_G) { const int kb = r / 88, nb = r % 88; transpose_item(p.ffn_wg + (size_t)l * DM * FFN, FFN, (bf16*)(wl + WO_GU), DM, 64 * kb, 32 * nb, 256 * (nb >> 2) + 32 * (nb & 3), 32, scr, lane); continue; } r -= I_G;
        if (r < I_G) { const int kb = r / 88, nb = r % 88; transpose_item(p.ffn_wu + (size_t)l * DM * FFN, FFN, (bf16*)(wl + WO_GU), DM, 64 * kb, 32 * nb, 256 * (nb >> 2) + 128 + 32 * (nb & 3), 32, scr, lane); continue; } r -= I_G;
        { const int kb = r / 32, nb = r % 32; transpose_item(p.ffn_wd + (size_t)l * FFN * DM, DM, (bf16*)(wl + WO_D), FFN, 64 * kb, 32 * nb, 32 * nb, 32, scr, lane); }
    }
}

template <bool RES, bool XBOUT>
__device__ __forceinline__ void row_pass(const float* xi, const float* h, const float* gpost, float* xo, const float* gpre, bf16* xb, int nrows) {
    const int tid = opaque_tid(), lane = tid & 63, wave = __builtin_amdgcn_readfirstlane(tid >> 6), gw = blockIdx.x * NWAVES + wave, NGW = gridDim.x * NWAVES;
    for (int m = gw; m < nrows; m += NGW) {
        const f32x4* xr = (const f32x4*)(xi + (size_t)m * DM) + lane;
        f32x4 v[4];
#pragma unroll
        for (int j = 0; j < 4; ++j) v[j] = xr[64 * j];
        if (RES) {
            const f32x4* hr = (const f32x4*)(h + (size_t)m * DM) + lane; f32x4 hv[4]; float s = 0.f;
#pragma unroll
            for (int j = 0; j < 4; ++j) { hv[j] = hr[64 * j]; s += (hv[j].x * hv[j].x + hv[j].y * hv[j].y) + (hv[j].z * hv[j].z + hv[j].w * hv[j].w); }
            const float r1 = rsqrtf(wave_sum(s) * (1.f / DM) + RMS_EPS);
            f32x4* xw = (f32x4*)(xo + (size_t)m * DM) + lane;
#pragma unroll
            for (int j = 0; j < 4; ++j) { const f32x4 g = ((const f32x4*)gpost)[lane + 64 * j]; v[j] = v[j] + hv[j] * r1 * g; xw[64 * j] = v[j]; }
        }
        if (XBOUT) {
            float s2 = 0.f;
#pragma unroll
            for (int j = 0; j < 4; ++j) s2 += (v[j].x * v[j].x + v[j].y * v[j].y) + (v[j].z * v[j].z + v[j].w * v[j].w);
            const float r2 = rsqrtf(wave_sum(s2) * (1.f / DM) + RMS_EPS);
            unsigned long long* o8 = (unsigned long long*)(xb + (size_t)m * DM) + lane;
#pragma unroll
            for (int j = 0; j < 4; ++j) { const f32x4 g = ((const f32x4*)gpre)[lane + 64 * j]; const f32x4 y = v[j] * r2 * g;
                o8[64 * j] = (unsigned long long)pk2(y.x, y.y) | ((unsigned long long)pk2(y.z, y.w) << 32); }
        }
    }
}

__device__ __forceinline__ float gelu_tanh(float x) { return 0.5f * x * (1.0f + tanhf(0.7978845608028654f * (x + 0.044715f * x * x * x))); }
__device__ __forceinline__ void compress_item(const Params& p, int l, int item, LAS unsigned char* lds) {
    const int tid = opaque_tid();
    const int b = item / 127, i = item % 127;
    LAS float* flat = (LAS float*)lds;
    LAS float* hid = flat + 4 * 2048;
    const bf16* proj = (const bf16*)(p.ws + WS_PROJ);
    const float* pe = p.cmp_pe + (size_t)l * 32 * 64;
    for (int e = tid; e < 4 * 2048; e += NTHREADS) { const int r = e >> 11, k = e & 2047, pp = k >> 6, d = k & 63, g = r & 1, kv = r >> 1;
        const bf16 v = proj[(size_t)(b * SEQ + 16 * i + pp) * PROJ_LD + (kv ? CVC : CKC) + g * 64 + d];
        flat[e] = __uint_as_float((unsigned)v << 16) + pe[pp * 64 + d]; }
    __syncthreads();
    { const int r = tid >> 7, j = tid & 127, kv = r >> 1;
      const float* w1 = (kv ? p.cv1 : p.ck1) + (size_t)l * 2048 * 128 + j; const LAS float* f = flat + r * 2048;
      float a0 = 0.f, a1 = 0.f, a2 = 0.f, a3 = 0.f;
#pragma unroll 2
      for (int k = 0; k < 2048; k += 4) { a0 += f[k] * w1[(size_t)k * 128]; a1 += f[k + 1] * w1[(size_t)(k + 1) * 128]; a2 += f[k + 2] * w1[(size_t)(k + 2) * 128]; a3 += f[k + 3] * w1[(size_t)(k + 3) * 128]; }
      hid[tid] = gelu_tanh((a0 + a1) + (a2 + a3)); }
    __syncthreads();
    if (tid < 256) { const int r = tid >> 6, e = tid & 63, g = r & 1, kv = r >> 1;
        const float* w2 = (kv ? p.cv2 : p.ck2) + (size_t)l * 128 * 64 + e; const LAS float* hh = hid + r * 128; float a = 0.f;
#pragma unroll 8
        for (int j = 0; j < 128; ++j) a += hh[j] * w2[j * 64];
        bf16* dst = (bf16*)(p.ws + (kv ? WS_VCMP : WS_KCMP)); dst[((size_t)(b * 2 + g) * 128 + i) * 64 + e] = (bf16)f2bf(a); }
    __syncthreads();
}

__device__ __forceinline__ void conv_part(const Params& p, int ly, int b, int ch, const bf16* proj, bf16* xb, int lane, int wave) {
    {
        const float* cw = p.conv_w + (size_t)ly * 3 * 512 + lane * 8; const float* gn = p.gn_conv + (size_t)ly * 512 + lane * 8;
        for (int tq = wave; tq < 64; tq += NWAVES) {
            const int t = 64 * ch + tq; const size_t row = (size_t)b * SEQ + t;
            float y[8];
#pragma unroll
            for (int e = 0; e < 8; ++e) y[e] = 0.f;
#pragma unroll
            for (int k = 0; k < 3; ++k) if (t - k >= 0) {
                const u32x4 cc = *(const u32x4*)(proj + (row - k) * PROJ_LD + CCC + lane * 8), cx = *(const u32x4*)(proj + (row - k) * PROJ_LD + CCX + lane * 8);
                const float* w = cw + k * 512;
                y[0] += w[0] * bflo(cc.x) * bflo(cx.x); y[1] += w[1] * bfhi(cc.x) * bfhi(cx.x); y[2] += w[2] * bflo(cc.y) * bflo(cx.y); y[3] += w[3] * bfhi(cc.y) * bfhi(cx.y);
                y[4] += w[4] * bflo(cc.z) * bflo(cx.z); y[5] += w[5] * bfhi(cc.z) * bfhi(cx.z); y[6] += w[6] * bflo(cc.w) * bflo(cx.w); y[7] += w[7] * bfhi(cc.w) * bfhi(cx.w); }
            const u32x4 cb = *(const u32x4*)(proj + row * PROJ_LD + CCB + lane * 8);
            y[0] *= bflo(cb.x); y[1] *= bfhi(cb.x); y[2] *= bflo(cb.y); y[3] *= bfhi(cb.y); y[4] *= bflo(cb.z); y[5] *= bfhi(cb.z); y[6] *= bflo(cb.w); y[7] *= bfhi(cb.w);
            float ss = 0.f;
#pragma unroll
            for (int e = 0; e < 8; ++e) ss += y[e] * y[e];
            const float r = rsqrtf(wave_sum(ss) * (1.f / 512.f) + RMS_EPS);
            u32x4 w; w.x = pk2(y[0] * r * gn[0], y[1] * r * gn[1]); w.y = pk2(y[2] * r * gn[2], y[3] * r * gn[3]); w.z = pk2(y[4] * r * gn[4], y[5] * r * gn[5]); w.w = pk2(y[6] * r * gn[6], y[7] * r * gn[7]);
            *(u32x4*)(xb + row * DM + 512 + lane * 8) = w;
        }
    }
}

struct Soft { float m, l; };
#define ATT_ROW_BF16(kptr, vptr, biasv) do { \
    const u32x4* kp_ = (const u32x4*)(kptr); float s_ = 0.f; \
    _Pragma("unroll") for (int c_ = 0; c_ < 8; ++c_) { const u32x4 kk_ = kp_[c_]; \
        s_ += q[8 * c_ + 0] * bflo(kk_.x) + q[8 * c_ + 1] * bfhi(kk_.x) + q[8 * c_ + 2] * bflo(kk_.y) + q[8 * c_ + 3] * bfhi(kk_.y) + q[8 * c_ + 4] * bflo(kk_.z) + q[8 * c_ + 5] * bfhi(kk_.z) + q[8 * c_ + 6] * bflo(kk_.w) + q[8 * c_ + 7] * bfhi(kk_.w); } \
    s_ = s_ * 0.125f + (biasv); \
    if (s_ > m) { const float f_ = __expf(m - s_); l *= f_; _Pragma("unroll") for (int d_ = 0; d_ < 64; ++d_) o[d_] *= f_; m = s_; } \
    const float p_ = __expf(s_ - m); l += p_; const u32x4* vp_ = (const u32x4*)(vptr); \
    _Pragma("unroll") for (int c_ = 0; c_ < 8; ++c_) { const u32x4 vv_ = vp_[c_]; \
        o[8 * c_ + 0] += p_ * bflo(vv_.x); o[8 * c_ + 1] += p_ * bfhi(vv_.x); o[8 * c_ + 2] += p_ * bflo(vv_.y); o[8 * c_ + 3] += p_ * bfhi(vv_.y); \
        o[8 * c_ + 4] += p_ * bflo(vv_.z); o[8 * c_ + 5] += p_ * bfhi(vv_.z); o[8 * c_ + 6] += p_ * bflo(vv_.w); o[8 * c_ + 7] += p_ * bfhi(vv_.w); } } while (0)

#ifdef NSA_NAIVE
__device__ __forceinline__ void nsa_item(const Params& p, int ly, int item, LAS unsigned char* lds) {
    const int tid = opaque_tid();
    const int b = item >> 5, ch = item & 31, lane = tid & 63, wave = __builtin_amdgcn_readfirstlane(tid >> 6);
    LAS float* PS = (LAS float*)lds;
    LAS float* IMP = PS + 64 * 2 * 128;
    LAS unsigned* SELM = (LAS unsigned*)(IMP + 64 * 2 * 32);
    LAS float* RB = (LAS float*)(SELM + 128);
    LAS int* BK = (LAS int*)(RB + 256);
    const bf16* proj = (const bf16*)(p.ws + WS_PROJ);
    bf16* xb = (bf16*)(p.ws + WS_XB);
    for (int e = tid; e < 64 * 2 * 128; e += NTHREADS) PS[e] = 0.f;
    if (tid < 256) RB[tid] = p.rel_bias[tid];
    if (tid < 128) BK[tid] = T5_BUCKET[tid];
    conv_part(p, ly, b, ch, proj, xb, lane, wave);
    __syncthreads();
    const int ql = tid >> 3, h = tid & 7, g = h >> 2, t = 64 * ch + ql; const size_t row = (size_t)b * SEQ + t;
    float q[64], o[64];
    float* outp = (float*)(p.ws + WS_H) + row * DM + h * 64;
    { const u32x4* qp = (const u32x4*)(proj + row * PROJ_LD + CQ + h * 64);
#pragma unroll
      for (int c = 0; c < 8; ++c) { const u32x4 v = qp[c]; q[8 * c] = bflo(v.x); q[8 * c + 1] = bfhi(v.x); q[8 * c + 2] = bflo(v.y); q[8 * c + 3] = bfhi(v.y); q[8 * c + 4] = bflo(v.z); q[8 * c + 5] = bfhi(v.z); q[8 * c + 6] = bflo(v.w); q[8 * c + 7] = bfhi(v.w); } }
    const bf16* gl = proj + row * PROJ_LD + CGL + h * 3;
    const float g0 = 1.f / (1.f + __expf(-__uint_as_float((unsigned)gl[0] << 16))), g1 = 1.f / (1.f + __expf(-__uint_as_float((unsigned)gl[1] << 16))), g2 = 1.f / (1.f + __expf(-__uint_as_float((unsigned)gl[2] << 16)));
    const LAS float* rb = RB + h * 32;
    {
        const int ncv = (t >= 31) ? ((t - 15) >> 4) : 0, nmax = 4 * ch + 3 > 127 ? 127 : 4 * ch + 3;
        const float* kc = (const float*)(p.ws + WS_KCMP) + ((size_t)b * 128 * 2 + g) * 64; const float* vc = (const float*)(p.ws + WS_VCMP) + ((size_t)b * 128 * 2 + g) * 64;
        float m = -1e30f, l = 0.f;
        for (int n = 0; n < ncv; ++n) { const f32x4* kp = (const f32x4*)(kc + (size_t)n * 128); float s = 0.f;
#pragma unroll
            for (int c = 0; c < 16; ++c) { const f32x4 kk = kp[c]; s += q[4 * c] * kk.x + q[4 * c + 1] * kk.y + q[4 * c + 2] * kk.z + q[4 * c + 3] * kk.w; }
            s = s * 0.125f + rb[BK[min(t - 16 * n - 31, 127)]];
            if (s > m) { l *= __expf(m - s); m = s; } l += __expf(s - m); }
        const float il = l > 0.f ? 1.f / l : 0.f;
#pragma unroll
        for (int d = 0; d < 64; ++d) o[d] = 0.f;
        for (int n = 0; n < nmax; ++n) { float pn = 0.f;
            if (n < ncv) { const f32x4* kp = (const f32x4*)(kc + (size_t)n * 128); float s = 0.f;
#pragma unroll
                for (int c = 0; c < 16; ++c) { const f32x4 kk = kp[c]; s += q[4 * c] * kk.x + q[4 * c + 1] * kk.y + q[4 * c + 2] * kk.z + q[4 * c + 3] * kk.w; }
                s = s * 0.125f + rb[BK[min(t - 16 * n - 31, 127)]];
                pn = __expf(s - m) * il;
                const f32x4* vp = (const f32x4*)(vc + (size_t)n * 128);
#pragma unroll
                for (int c = 0; c < 16; ++c) { const f32x4 vv = vp[c]; o[4 * c] += pn * vv.x; o[4 * c + 1] += pn * vv.y; o[4 * c + 2] += pn * vv.z; o[4 * c + 3] += pn * vv.w; } }
            float ps = pn; ps += __shfl_xor(ps, 1); ps += __shfl_xor(ps, 2);
            if ((h & 3) == 0) PS[(ql * 2 + g) * 128 + n] = ps; }
#pragma unroll
        for (int c = 0; c < 16; ++c) ((f32x4*)outp)[c] = (f32x4){g0 * o[4 * c], g0 * o[4 * c + 1], g0 * o[4 * c + 2], g0 * o[4 * c + 3]};
    }
    __syncthreads();
    for (int e = tid; e < 64 * 2 * 32; e += NTHREADS) { const int j = e & 31; const LAS float* ps = PS + (e >> 5) * 128 + 4 * j;
        IMP[e] = (j > 0 ? 0.5f * ps[-1] : 0.f) + ps[0] + ps[1] + ps[2] + 0.5f * ps[3]; }
    __syncthreads();
    if (tid < 128) { unsigned mask;
        if (ch < 8) mask = (1u << (ch + 1)) - 1u;
        else { mask = 1u | (1u << ch) | (1u << (ch - 1)); const LAS float* im = IMP + tid * 32;
            for (int r = 0; r < 5; ++r) { int best = 1; float bv = -1.f;
                for (int j = 1; j <= ch - 2; ++j) { const float v = im[j]; if (!((mask >> j) & 1u) && v > bv) { bv = v; best = j; } }
                mask |= 1u << best; } }
        SELM[tid] = mask; }
    __syncthreads();
    {
        unsigned mask = SELM[ql * 2 + g]; const int cnt = ch < 8 ? ch + 1 : 8;
        float m = -1e30f, l = 0.f;
#pragma unroll
        for (int d = 0; d < 64; ++d) o[d] = 0.f;
        for (int it = 0; it < cnt; ++it) { const int j = __builtin_ctz(mask); mask &= mask - 1u;
            const bf16* kb = proj + ((size_t)b * SEQ + 64 * j) * PROJ_LD + CKS + g * 64;
            for (int kk = 0; kk < 64; ++kk) { const int dist = t - (64 * j + kk);
                if (dist >= 0) ATT_ROW_BF16(kb + (size_t)kk * PROJ_LD, kb + (size_t)kk * PROJ_LD + (CVS - CKS), rb[BK[min(dist, 127)]]); } }
        const float w = g1 / l;
#pragma unroll
        for (int c = 0; c < 16; ++c) { f32x4 a = ((f32x4*)outp)[c]; a.x += w * o[4 * c]; a.y += w * o[4 * c + 1]; a.z += w * o[4 * c + 2]; a.w += w * o[4 * c + 3]; ((f32x4*)outp)[c] = a; }
    }
    {
        float m = -1e30f, l = 0.f;
#pragma unroll
        for (int d = 0; d < 64; ++d) o[d] = 0.f;
        for (int kk = 0; kk < 256; ++kk) { const int pos = t - 255 + kk;
            if (pos >= 0) { const bf16* kb = proj + ((size_t)b * SEQ + pos) * PROJ_LD + CKW + g * 64; ATT_ROW_BF16(kb, kb + (CVW - CKW), rb[BK[min(255 - kk, 127)]]); } }
        const float w = g2 / l;
#pragma unroll
        for (int c = 0; c < 16; ++c) { const f32x4 a = ((f32x4*)outp)[c]; o[4 * c] = a.x + w * o[4 * c]; o[4 * c + 1] = a.y + w * o[4 * c + 1]; o[4 * c + 2] = a.z + w * o[4 * c + 2]; o[4 * c + 3] = a.w + w * o[4 * c + 3]; }
    }
    { float ss = 0.f;
#pragma unroll
      for (int d = 0; d < 64; ++d) ss += o[d] * o[d];
      ss += __shfl_xor(ss, 1); ss += __shfl_xor(ss, 2); ss += __shfl_xor(ss, 4);
      const float r = rsqrtf(ss * (1.f / 512.f) + RMS_EPS); const float* gn = p.gn_nsa + (size_t)ly * 512 + h * 64;
      u32x4* dst = (u32x4*)(xb + row * DM + h * 64);
#pragma unroll
      for (int c = 0; c < 8; ++c) { u32x4 w; w.x = pk2(o[8 * c] * r * gn[8 * c], o[8 * c + 1] * r * gn[8 * c + 1]); w.y = pk2(o[8 * c + 2] * r * gn[8 * c + 2], o[8 * c + 3] * r * gn[8 * c + 3]);
          w.z = pk2(o[8 * c + 4] * r * gn[8 * c + 4], o[8 * c + 5] * r * gn[8 * c + 5]); w.w = pk2(o[8 * c + 6] * r * gn[8 * c + 6], o[8 * c + 7] * r * gn[8 * c + 7]); dst[c] = w; } }
    __syncthreads();
}

#endif

namespace nsa {
typedef short bf16x8 __attribute__((ext_vector_type(8)));
typedef float f32x16 __attribute__((ext_vector_type(16)));
typedef short s16x4 __attribute__((ext_vector_type(4)));
constexpr int KROWB = 144, KT_BYTES = 64 * KROWB, VT_BYTES = 8192;
constexpr int L_K = 0, L_V = 2 * KT_BYTES, L_TB = L_V + 2 * VT_BYTES, L_TBC = L_TB + 8 * 384 * 4, L_IMPA = L_TBC + 8 * 132 * 4, L_IMPB = L_IMPA + 8192, L_SELM = L_IMPB + 8192, L_END = L_SELM + 256;
constexpr float LOG2E = 1.4426950408889634f, QSCALE = 0.125f * LOG2E, NEG = -2e30f, MINIT = -1e30f;

__device__ __forceinline__ void build_tables(const float* rel_bias, LAS unsigned char* lds, int tid) {
    LAS float* TB = (LAS float*)(lds + L_TB); LAS float* TBC = (LAS float*)(lds + L_TBC);
    for (int e = tid; e < 8 * 384; e += NTHREADS) { const int h = e / 384, x = e % 384, dist = 319 - x; TB[e] = (dist < 0 || dist > 255) ? NEG : rel_bias[h * 32 + T5_BUCKET[dist > 127 ? 127 : dist]] * LOG2E; }
    for (int e = tid; e < 8 * 132; e += NTHREADS) { const int h = e / 132, idx = e % 132; TBC[e] = (idx == 0 || idx > 128) ? NEG : rel_bias[h * 32 + T5_BUCKET[idx - 1]] * LOG2E; }
    __syncthreads();
}
template <int CTRL> __device__ __forceinline__ float dppf(float x) { return __builtin_bit_cast(float, __builtin_amdgcn_update_dpp(0, __builtin_bit_cast(int, x), CTRL, 0xf, 0xf, true)); }
__device__ __forceinline__ float quad_sum(float x) { x += dppf<0xB1>(x); x += dppf<0x4E>(x); return x; }
__device__ __forceinline__ unsigned cvtpk(float lo, float hi) { unsigned r; asm volatile("v_cvt_pk_bf16_f32 %0, %1, %2" : "=v"(r) : "v"(lo), "v"(hi)); return r; }
__device__ __forceinline__ s16x4 tr_read(LAS const unsigned char* p) { typedef short v4i16_t __attribute__((ext_vector_type(4))); return __builtin_bit_cast(s16x4, __builtin_amdgcn_ds_read_tr16_b64_v4i16((LAS v4i16_t*)p)); }

struct TileSrc { const bf16* K; const bf16* V; int stride; };
__device__ __forceinline__ void qk_tile(f32x16& p0, f32x16& p1, LAS const unsigned char* kt, const bf16x8 (&qf)[4], int r32, int hi) {
    LAS const unsigned char* kb = kt + r32 * KROWB + hi * 16;
#pragma unroll
    for (int d0 = 0; d0 < 4; ++d0) {
        const bf16x8 a0 = *(LAS const bf16x8*)(kb + d0 * 32), a1 = *(LAS const bf16x8*)(kb + 32 * KROWB + d0 * 32);
        p0 = __builtin_amdgcn_mfma_f32_32x32x16_bf16(a0, qf[d0], p0, 0, 0, 0); p1 = __builtin_amdgcn_mfma_f32_32x32x16_bf16(a1, qf[d0], p1, 0, 0, 0); }
}
__device__ __forceinline__ void pv_tile(f32x16 (&o)[2], LAS const unsigned char* vt, const u32x4 (&pw)[4], int lane) {
    const int hi = lane >> 5, grp = (lane >> 4) & 1, i = lane & 15;
    LAS const unsigned char* vb = vt + (4 * hi + (i >> 2)) * 64 + (16 * grp + 4 * (i & 3)) * 2;
#pragma unroll
    for (int dblk = 0; dblk < 2; ++dblk)
#pragma unroll
        for (int s = 0; s < 4; ++s) {
            const s16x4 lo = tr_read(vb + dblk * 4096 + (16 * s) * 64), hi4 = tr_read(vb + dblk * 4096 + (16 * s + 8) * 64);
            const bf16x8 vf = (bf16x8){lo[0], lo[1], lo[2], lo[3], hi4[0], hi4[1], hi4[2], hi4[3]};
            o[dblk] = __builtin_amdgcn_mfma_f32_32x32x16_bf16(vf, __builtin_bit_cast(bf16x8, pw[s]), o[dblk], 0, 0, 0); }
}
__device__ __forceinline__ float vmax16(const f32x16& a, const f32x16& b) {
    float x = fmaxf(a[0], b[0]);
#pragma unroll
    for (int r = 1; r < 16; ++r) x = fmaxf(x, fmaxf(a[r], b[r]));
    return x;
}
__device__ __forceinline__ void pack_p(u32x4 (&pw)[4], const f32x16& p0, const f32x16& p1) {
    pw[0] = (u32x4){cvtpk(p0[0], p0[1]), cvtpk(p0[2], p0[3]), cvtpk(p0[4], p0[5]), cvtpk(p0[6], p0[7])};
    pw[1] = (u32x4){cvtpk(p0[8], p0[9]), cvtpk(p0[10], p0[11]), cvtpk(p0[12], p0[13]), cvtpk(p0[14], p0[15])};
    pw[2] = (u32x4){cvtpk(p1[0], p1[1]), cvtpk(p1[2], p1[3]), cvtpk(p1[4], p1[5]), cvtpk(p1[6], p1[7])};
    pw[3] = (u32x4){cvtpk(p1[8], p1[9]), cvtpk(p1[10], p1[11]), cvtpk(p1[12], p1[13]), cvtpk(p1[14], p1[15])};
}
template <bool LOOKUP>
__device__ __forceinline__ void soft_tile(f32x16& p0, f32x16& p1, LAS const float* tbp, float& m, float& l, f32x16 (&o)[2], u32x4 (&pw)[4]) {
    if (LOOKUP) {
#pragma unroll
        for (int r = 0; r < 16; ++r) { p0[r] += tbp[(r & 3) + 8 * (r >> 2)]; p1[r] += tbp[32 + (r & 3) + 8 * (r >> 2)]; }
    }
    float mx = vmax16(p0, p1); mx = fmaxf(mx, __shfl_xor(mx, 32));
    const float mn = fmaxf(m, mx), alpha = __builtin_amdgcn_exp2f(m - mn); m = mn;
    float rs = 0.f;
#pragma unroll
    for (int r = 0; r < 16; ++r) { p0[r] = __builtin_amdgcn_exp2f(p0[r] - mn); p1[r] = __builtin_amdgcn_exp2f(p1[r] - mn); rs += p0[r] + p1[r]; }
    l = l * alpha + rs;
#pragma unroll
    for (int r = 0; r < 16; ++r) { o[0][r] *= alpha; o[1][r] *= alpha; }
    pack_p(pw, p0, p1);
}

__device__ __forceinline__ void nsa_unit(const Params& p, int b, int c, int g, LAS unsigned char* lds, int tid) {
    const int lane = tid & 63, w = __builtin_amdgcn_readfirstlane(tid >> 6), r32 = lane & 31, hi = lane >> 5, qi = r32 >> 2, hh = r32 & 3, h = 4 * g + hh, ql = 8 * w + qi, t = 64 * c + ql;
    const size_t row = (size_t)b * SEQ + t;
    const bf16* proj = (const bf16*)(p.ws + WS_PROJ);
    const bf16* kcb = (const bf16*)(p.ws + WS_KCMP) + (size_t)(b * 2 + g) * 128 * 64; const bf16* vcb = (const bf16*)(p.ws + WS_VCMP) + (size_t)(b * 2 + g) * 128 * 64;
    const int skey = tid >> 3, sch = tid & 7;
    LAS unsigned char* kdst = lds + L_K + skey * KROWB + sch * 16; LAS unsigned char* vdst = lds + L_V + (sch >> 2) * 4096 + skey * 64 + (sch & 3) * 16;
    const int NT = 2 + (c + 1) + (c + 1 < 5 ? c + 1 : 5), w0 = c > 4 ? c - 4 : 0;
#define NSA_SRC(i, S_) do { if ((i) < 2) { S_.K = kcb + (size_t)(64 * (i)) * 64; S_.V = vcb + (size_t)(64 * (i)) * 64; S_.stride = 64; } \
        else if ((i) < 3 + c) { S_.K = proj + ((size_t)b * SEQ + 64 * ((i) - 2)) * PROJ_LD + CKS + 64 * g; S_.V = S_.K + (CVS - CKS); S_.stride = PROJ_LD; } \
        else { S_.K = proj + ((size_t)b * SEQ + 64 * (w0 + (i) - 3 - c)) * PROJ_LD + CKW + 64 * g; S_.V = S_.K + (CVW - CKW); S_.stride = PROJ_LD; } } while (0)
#define NSA_LOAD(i) do { TileSrc s_; NSA_SRC(i, s_); kreg = *(const u32x4*)(s_.K + (size_t)skey * s_.stride + sch * 8); vreg = *(const u32x4*)(s_.V + (size_t)skey * s_.stride + sch * 8); } while (0)
#define NSA_WRITE(buf) do { *(LAS u32x4*)(kdst + (buf) * KT_BYTES) = kreg; *(LAS u32x4*)(vdst + (buf) * VT_BYTES) = vreg; } while (0)
    u32x4 kreg, vreg;
    NSA_LOAD(0);
    bf16x8 qf[4];
#pragma unroll
    for (int d0 = 0; d0 < 4; ++d0) qf[d0] = *(const bf16x8*)(proj + row * PROJ_LD + CQ + h * 64 + 16 * d0 + 8 * hi);
    const bf16* gl = proj + row * PROJ_LD + CGL + h * 3;
    const float g0 = 1.f / (1.f + __expf(-__uint_as_float((unsigned)gl[0] << 16))), g1 = 1.f / (1.f + __expf(-__uint_as_float((unsigned)gl[1] << 16))), g2 = 1.f / (1.f + __expf(-__uint_as_float((unsigned)gl[2] << 16)));
    NSA_WRITE(0);
    __syncthreads();
    f32x16 o[2], out[2]; u32x4 pw[4];
    LAS const float* TBh = (LAS const float*)(lds + L_TB) + h * 384; LAS const float* TBCh = (LAS const float*)(lds + L_TBC) + h * 132;
    const float rb31 = TBCh[128];
    unsigned selm;
    {
        f32x16 pa0, pa1, pb0, pb1;
#pragma unroll
        for (int r = 0; r < 16; ++r) { pa0[r] = 0.f; pa1[r] = 0.f; pb0[r] = 0.f; pb1[r] = 0.f; }
        NSA_LOAD(1);
        qk_tile(pa0, pa1, lds + L_K, qf, r32, hi);
        NSA_WRITE(1);
        __syncthreads();
        NSA_LOAD(2);
        qk_tile(pb0, pb1, lds + L_K + KT_BYTES, qf, r32, hi);
        const int Dc = t - 31 - 64 * hi;
#pragma unroll
        for (int r = 0; r < 16; ++r) { const int nr = (r & 3) + 8 * (r >> 2);
            { const int d = Dc - 16 * nr; pa0[r] += TBCh[min(max(d, -1), 127) + 1]; }
            { const int d = Dc - 16 * (32 + nr); pa1[r] += TBCh[min(max(d, -1), 127) + 1]; }
            { const int d = Dc - 16 * (64 + nr); pb0[r] += TBCh[min(max(d, -1), 127) + 1]; }
            { const int d = Dc - 16 * (96 + nr); pb1[r] += TBCh[min(max(d, -1), 127) + 1]; } }
        float mx = fmaxf(vmax16(pa0, pa1), vmax16(pb0, pb1)); mx = fmaxf(mx, __shfl_xor(mx, 32)); mx = fmaxf(mx, MINIT);
        float rs = 0.f;
#pragma unroll
        for (int r = 0; r < 16; ++r) { pa0[r] = __builtin_amdgcn_exp2f(pa0[r] - mx); pa1[r] = __builtin_amdgcn_exp2f(pa1[r] - mx); pb0[r] = __builtin_amdgcn_exp2f(pb0[r] - mx); pb1[r] = __builtin_amdgcn_exp2f(pb1[r] - mx);
            rs += (pa0[r] + pa1[r]) + (pb0[r] + pb1[r]); }
        rs += __shfl_xor(rs, 32);
        const float il = rs > 0.f ? 1.f / rs : 0.f;
#pragma unroll
        for (int r = 0; r < 16; ++r) { pa0[r] *= il; pa1[r] *= il; pb0[r] *= il; pb1[r] *= il; }
        LAS float* IA = (LAS float*)(lds + L_IMPA) + w * 256 + qi * 32; LAS float* IB = (LAS float*)(lds + L_IMPB) + w * 256 + qi * 32;
#pragma unroll
        for (int k = 0; k < 4; ++k) {
            const float a0 = quad_sum((pa0[4 * k] + pa0[4 * k + 1]) + (pa0[4 * k + 2] + 0.5f * pa0[4 * k + 3])), b0 = quad_sum(0.5f * pa0[4 * k + 3]);
            const float a1 = quad_sum((pa1[4 * k] + pa1[4 * k + 1]) + (pa1[4 * k + 2] + 0.5f * pa1[4 * k + 3])), b1 = quad_sum(0.5f * pa1[4 * k + 3]);
            const float a2 = quad_sum((pb0[4 * k] + pb0[4 * k + 1]) + (pb0[4 * k + 2] + 0.5f * pb0[4 * k + 3])), b2 = quad_sum(0.5f * pb0[4 * k + 3]);
            const float a3 = quad_sum((pb1[4 * k] + pb1[4 * k + 1]) + (pb1[4 * k + 2] + 0.5f * pb1[4 * k + 3])), b3 = quad_sum(0.5f * pb1[4 * k + 3]);
            if (hh == 0) { const int j = 2 * k + hi; IA[j] = a0; IB[j] = b0; IA[8 + j] = a1; IB[8 + j] = b1; IA[16 + j] = a2; IB[16 + j] = b2; IA[24 + j] = a3; IB[24 + j] = b3; } }
        asm volatile("s_waitcnt lgkmcnt(0)" ::: "memory");
        if (lane < 8) { unsigned mask;
            if (c < 8) mask = (1u << (c + 1)) - 1u;
            else { mask = 1u | (1u << c) | (1u << (c - 1));
                LAS const float* A = (LAS const float*)(lds + L_IMPA) + w * 256 + lane * 32; LAS const float* B = (LAS const float*)(lds + L_IMPB) + w * 256 + lane * 32;
                for (int rr = 0; rr < 5; ++rr) { int best = 1; float bv = -1.f;
                    for (int j = 1; j <= c - 2; ++j) { const float v = A[j] + B[j - 1]; if (!((mask >> j) & 1u) && v > bv) { bv = v; best = j; } }
                    mask |= 1u << best; } }
            ((LAS unsigned*)(lds + L_SELM))[w * 8 + lane] = mask; }
        asm volatile("s_waitcnt lgkmcnt(0)" ::: "memory");
        selm = ((LAS const unsigned*)(lds + L_SELM))[w * 8 + qi];
#pragma unroll
        for (int r = 0; r < 16; ++r) { o[0][r] = 0.f; o[1][r] = 0.f; }
        pack_p(pw, pa0, pa1); pv_tile(o, lds + L_V, pw, lane);
        pack_p(pw, pb0, pb1); pv_tile(o, lds + L_V + VT_BYTES, pw, lane);
#pragma unroll
        for (int r = 0; r < 16; ++r) { out[0][r] = g0 * o[0][r]; out[1][r] = g0 * o[1][r]; o[0][r] = 0.f; o[1][r] = 0.f; }
        __syncthreads();
        NSA_WRITE(0);
        __syncthreads();
    }
    float m = MINIT, l = 0.f;
    for (int i = 2; i < NT; ++i) {
        const bool more = i + 1 < NT;
        if (more) NSA_LOAD(i + 1);
        const bool win = i >= 3 + c; const int j = win ? w0 + i - 3 - c : i - 2, dj = c - j;
        const bool lookup = dj <= 2 || (win && dj == 4);
        const bool on = win || ((selm >> j) & 1u);
        const float cb = lookup ? (on ? 0.f : NEG) : (on ? rb31 : NEG);
        f32x16 p0, p1;
#pragma unroll
        for (int r = 0; r < 16; ++r) { p0[r] = cb; p1[r] = cb; }
        LAS const unsigned char* kt = lds + L_K + (i & 1) * KT_BYTES; LAS const unsigned char* vt = lds + L_V + (i & 1) * VT_BYTES;
        qk_tile(p0, p1, kt, qf, r32, hi);
        if (lookup) soft_tile<true>(p0, p1, TBh + (319 - (64 * dj + ql) + 4 * hi), m, l, o, pw);
        else soft_tile<false>(p0, p1, TBh, m, l, o, pw);
        pv_tile(o, vt, pw, lane);
        if (i == 2 + c || i == NT - 1) {
            const float lt = l + __shfl_xor(l, 32), wgt = (win ? g2 : g1) / lt;
#pragma unroll
            for (int r = 0; r < 16; ++r) { out[0][r] += wgt * o[0][r]; out[1][r] += wgt * o[1][r]; o[0][r] = 0.f; o[1][r] = 0.f; }
            m = MINIT; l = 0.f; }
        if (more) NSA_WRITE((i + 1) & 1);
        __syncthreads();
    }
    float* outp = (float*)(p.ws + WS_H) + row * DM + h * 64 + 4 * hi;
#pragma unroll
    for (int dblk = 0; dblk < 2; ++dblk)
#pragma unroll
        for (int k = 0; k < 4; ++k) *(f32x4*)(outp + 32 * dblk + 8 * k) = (f32x4){out[dblk][4 * k], out[dblk][4 * k + 1], out[dblk][4 * k + 2], out[dblk][4 * k + 3]};
#undef NSA_SRC
#undef NSA_LOAD
#undef NSA_WRITE
}
}

__device__ __forceinline__ void nsa_item_mfma(const Params& p, int ly, int item, LAS unsigned char* lds) {
    const int tid = opaque_tid();
    const int b = item >> 5, ch = item & 31, lane = tid & 63, wave = __builtin_amdgcn_readfirstlane(tid >> 6);
    const bf16* proj = (const bf16*)(p.ws + WS_PROJ);
    bf16* xb = (bf16*)(p.ws + WS_XB);
    conv_part(p, ly, b, ch, proj, xb, lane, wave);
    nsa::nsa_unit(p, b, ch, 0, lds, tid);
    nsa::nsa_unit(p, b, ch, 1, lds, tid);
    __syncthreads();
    { const int ql = tid >> 3, h = tid & 7; const size_t row = (size_t)b * SEQ + 64 * ch + ql;
      const f32x4* src = (const f32x4*)((const float*)(p.ws + WS_H) + row * DM + h * 64); f32x4 v[16]; float ss = 0.f;
#pragma unroll
      for (int c = 0; c < 16; ++c) { v[c] = src[c]; ss += (v[c].x * v[c].x + v[c].y * v[c].y) + (v[c].z * v[c].z + v[c].w * v[c].w); }
      ss += __shfl_xor(ss, 1); ss += __shfl_xor(ss, 2); ss += __shfl_xor(ss, 4);
      const float r = rsqrtf(ss * (1.f / 512.f) + RMS_EPS); const f32x4* gn = (const f32x4*)(p.gn_nsa + (size_t)ly * 512 + h * 64);
      u32x4* dst = (u32x4*)(xb + row * DM + h * 64);
#pragma unroll
      for (int c = 0; c < 8; ++c) { const f32x4 a = v[2 * c] * r * gn[2 * c], bb = v[2 * c + 1] * r * gn[2 * c + 1]; u32x4 wv; wv.x = pk2(a.x, a.y); wv.y = pk2(a.z, a.w); wv.z = pk2(bb.x, bb.y); wv.w = pk2(bb.z, bb.w); dst[c] = wv; } }
    __syncthreads();
}

__device__ __forceinline__ void memattn_item(const Params& p, int ly, int item) {
    const int tid = opaque_tid();
    const int b = item >> 4, qt = item & 15, ql = tid >> 2, hm = tid & 3; const size_t row = (size_t)b * SEQ + 128 * qt + ql;
    const bf16* qm = (const bf16*)(p.ws + WS_QM); const bf16* kv = (const bf16*)(p.ws + WS_MEMKV) + (size_t)ly * 4096 * 512 + (size_t)b * MEML * 512 + hm * 64;
    float q[64], o[64];
    { const u32x4* qp = (const u32x4*)(qm + row * 256 + hm * 64);
#pragma unroll
      for (int c = 0; c < 8; ++c) { const u32x4 v = qp[c]; q[8 * c] = bflo(v.x); q[8 * c + 1] = bfhi(v.x); q[8 * c + 2] = bflo(v.y); q[8 * c + 3] = bfhi(v.y); q[8 * c + 4] = bflo(v.z); q[8 * c + 5] = bfhi(v.z); q[8 * c + 6] = bflo(v.w); q[8 * c + 7] = bfhi(v.w); } }
    float m = -1e30f, l = 0.f;
#pragma unroll
    for (int d = 0; d < 64; ++d) o[d] = 0.f;
    for (int k = 0; k < MEML; ++k) ATT_ROW_BF16(kv + (size_t)k * 512, kv + (size_t)k * 512 + 256, 0.f);
    const float il = 1.f / l;
    u32x4* dst = (u32x4*)((bf16*)(p.ws + WS_OM) + row * 256 + hm * 64);
#pragma unroll
    for (int c = 0; c < 8; ++c) { u32x4 w; w.x = pk2(o[8 * c] * il, o[8 * c + 1] * il); w.y = pk2(o[8 * c + 2] * il, o[8 * c + 3] * il); w.z = pk2(o[8 * c + 4] * il, o[8 * c + 5] * il); w.w = pk2(o[8 * c + 6] * il, o[8 * c + 7] * il); dst[c] = w; }
}

__device__ __forceinline__ void memattn_unit(const Params& p, int ly, int unit, LAS unsigned char* lds) {
    using namespace nsa;
    const int tid = opaque_tid(), lane = tid & 63, w = __builtin_amdgcn_readfirstlane(tid >> 6), r32 = lane & 31, hi = lane >> 5;
    const int b = unit >> 5, hm = (unit >> 3) & 3, qb = unit & 7;
    const bf16* kv = (const bf16*)(p.ws + WS_MEMKV) + (size_t)ly * 4096 * 512 + (size_t)b * MEML * 512 + hm * 64;
    constexpr int MK = 0, MV = 4 * KT_BYTES;
    { const int skey = tid >> 3, sch = tid & 7;
      u32x4 kr[4], vr[4];
#pragma unroll
      for (int tt = 0; tt < 4; ++tt) { kr[tt] = *(const u32x4*)(kv + (size_t)(64 * tt + skey) * 512 + sch * 8); vr[tt] = *(const u32x4*)(kv + (size_t)(64 * tt + skey) * 512 + 256 + sch * 8); }
#pragma unroll
      for (int tt = 0; tt < 4; ++tt) { *(LAS u32x4*)(lds + MK + tt * KT_BYTES + skey * KROWB + sch * 16) = kr[tt]; *(LAS u32x4*)(lds + MV + tt * VT_BYTES + (sch >> 2) * 4096 + skey * 64 + (sch & 3) * 16) = vr[tt]; } }
    const size_t row = (size_t)b * SEQ + 256 * qb + 32 * w + r32;
    bf16x8 qf[4];
#pragma unroll
    for (int d0 = 0; d0 < 4; ++d0) qf[d0] = *(const bf16x8*)((const bf16*)(p.ws + WS_QM) + row * 256 + hm * 64 + 16 * d0 + 8 * hi);
    __syncthreads();
    f32x16 o[2]; u32x4 pw[4]; float m = MINIT, l = 0.f;
#pragma unroll
    for (int r = 0; r < 16; ++r) { o[0][r] = 0.f; o[1][r] = 0.f; }
    for (int tt = 0; tt < 4; ++tt) {
        f32x16 p0, p1;
#pragma unroll
        for (int r = 0; r < 16; ++r) { p0[r] = 0.f; p1[r] = 0.f; }
        qk_tile(p0, p1, lds + MK + tt * KT_BYTES, qf, r32, hi);
        soft_tile<false>(p0, p1, (LAS const float*)lds, m, l, o, pw);
        pv_tile(o, lds + MV + tt * VT_BYTES, pw, lane);
    }
    const float il = 1.f / (l + __shfl_xor(l, 32));
    bf16* dst = (bf16*)(p.ws + WS_OM) + row * 256 + hm * 64 + 4 * hi;
#pragma unroll
    for (int dblk = 0; dblk < 2; ++dblk)
#pragma unroll
        for (int k = 0; k < 4; ++k) { const unsigned long long v = (unsigned long long)pk2(o[dblk][4 * k] * il, o[dblk][4 * k + 1] * il) | ((unsigned long long)pk2(o[dblk][4 * k + 2] * il, o[dblk][4 * k + 3] * il) << 32);
            *(unsigned long long*)(dst + 32 * dblk + 8 * k) = v; }
    __syncthreads();
}

#define XB_TMO      128
#define XB_XCNT(j)  (256  + 64 * (j))
#define XB_XSUB(j)  (1280 + 64 * (j))
#define XB_XGEN(j)  (2304 + 64 * (j))
#define XB_TOP      3328
#define XB_TOPGEN   3392
#define XCD_BAR_WORDS 3456
#define XB_SPIN_CAP (1u << 18)

__device__ __forceinline__ unsigned xb_ld(unsigned* p)              { return __hip_atomic_load(p, __ATOMIC_RELAXED, __HIP_MEMORY_SCOPE_AGENT); }
__device__ __forceinline__ unsigned xb_add(unsigned* p, unsigned v) { return __hip_atomic_fetch_add(p, v, __ATOMIC_RELAXED, __HIP_MEMORY_SCOPE_AGENT); }
__device__ __forceinline__ unsigned xb_xcc_id() { return (unsigned)__builtin_amdgcn_s_getreg((3 << 11) | 20) & 0xFu; }
#define XB_SPIN(cond, bar) do { unsigned _sp = 0; while (cond) { __builtin_amdgcn_s_sleep(1); \
    if ((++_sp & 255u) == 0u) { if (xb_ld(&(bar)[XB_TMO])) break; if (_sp > XB_SPIN_CAP) { atomicAdd(&(bar)[XB_TMO], 1u); break; } } } } while (0)

struct XcdBarrier {
    unsigned* bar; unsigned x;
    volatile LAS unsigned* st;
};

__device__ __forceinline__ XcdBarrier xcd_barrier_post(unsigned* bar, volatile LAS unsigned* st) {
    XcdBarrier b; b.bar = bar; b.x = xb_xcc_id(); b.st = st;
    if (opaque_tid() == 0) (void)xb_add(&bar[XB_XCNT(b.x)], 1u);
    return b;
}
__device__ __forceinline__ void xcd_barrier_complete(unsigned* bar, unsigned x, unsigned& nloc, unsigned& nx) {
    const unsigned G = gridDim.x * gridDim.y * gridDim.z;
    unsigned sum, cnt, mine, sp = 0u;
    for (;;) {
        sum = 0u; cnt = 0u; mine = 0u;
#pragma unroll
        for (unsigned j = 0; j < 16; ++j) { const unsigned c = xb_ld(&bar[XB_XCNT(j)]); sum += c; cnt += (c > 0u) ? 1u : 0u; mine = (j == x) ? c : mine; }
        if (sum == G) break;
        __builtin_amdgcn_s_sleep(1);
        if ((++sp & 255u) == 0u) { if (xb_ld(&bar[XB_TMO])) break; if (sp > XB_SPIN_CAP) { atomicAdd(&bar[XB_TMO], 1u); break; } }
    }
    nloc = mine > 0u ? mine : 1u; nx = cnt > 0u ? cnt : 1u;
}

__device__ __forceinline__ void xcd_barrier(const XcdBarrier& b) {
    asm volatile("s_waitcnt vmcnt(0)" ::: "memory");
    __syncthreads();
    if (opaque_tid() == 0) {
        unsigned* bar = b.bar;
        __builtin_amdgcn_s_waitcnt(0);
        unsigned nloc = b.st[0], nx = b.st[1];
        if (nloc == 0u) { xcd_barrier_complete(bar, b.x, nloc, nx); b.st[0] = nloc; b.st[1] = nx; }
        const unsigned old = xb_add(&bar[XB_XSUB(b.x)], 1u);
        const unsigned gen = old / nloc;
        if (old + 1u == (gen + 1u) * nloc) {
            __builtin_amdgcn_fence(__ATOMIC_RELEASE, "agent");
            asm volatile("s_waitcnt vmcnt(0)" ::: "memory");
            const unsigned og = xb_add(&bar[XB_TOP], 1u);
            const unsigned tg = og / nx;
            if (og + 1u == (tg + 1u) * nx) xb_add(&bar[XB_TOPGEN], 1u);
            else XB_SPIN(xb_ld(&bar[XB_TOPGEN]) == tg, bar);
            __builtin_amdgcn_fence(__ATOMIC_ACQUIRE, "agent");
            xb_add(&bar[XB_XGEN(b.x)], 1u);
            asm volatile("s_waitcnt vmcnt(0)" ::: "memory");
        } else {
            XB_SPIN(xb_ld(&bar[XB_XGEN(b.x)]) == gen, bar);
            __builtin_amdgcn_fence(__ATOMIC_ACQUIRE, "agent");
            asm volatile("s_waitcnt vmcnt(0)" ::: "memory");
        }
    }
    __syncthreads();
}

template <class Epi>
__device__ __forceinline__ void run_gemm(LAS unsigned char* lds, const bf16* A, const bf16* Bt, int M, int N, int K, const Epi& E) {
    pg8::Gemm g{A, Bt, M, N, K}; pg8::StaticOrder S; S.init(M, N, (int)gridDim.x, (int)blockIdx.x);
    pg8::gemm_phase<Epi, pg8::StaticOrder, true, true>(lds, g, S, E);
}

__global__ void __launch_bounds__(NTHREADS, 2) hymba_fwd(Params p) {
    extern __shared__ __attribute__((aligned(16))) unsigned char lds_raw[];
    LAS unsigned char* lds = (LAS unsigned char*)lds_raw;
    cg::grid_group grid = cg::this_grid();
    const int G = gridDim.x;
    unsigned char* ws = p.ws;
    bf16* XB = (bf16*)(ws + WS_XB); float* H = (float*)(ws + WS_H); bf16* PROJ = (bf16*)(ws + WS_PROJ); bf16* HID = PROJ;
    bf16* QM = (bf16*)(ws + WS_QM); bf16* OM = (bf16*)(ws + WS_OM); bf16* MEMN = (bf16*)(ws + WS_MEMN); bf16* MEMKV = (bf16*)(ws + WS_MEMKV);
    volatile LAS unsigned* MISC = (volatile LAS unsigned*)(lds + MISC_OFF);
    { const int t0 = opaque_tid(); if (t0 < 32) MISC[t0] = 0u; }
    __syncthreads();
    XcdBarrier bar = xcd_barrier_post((unsigned*)(ws + WS_CTL) + CW_BAR, MISC + 8);
    int ph = 0;
#define PHASE_BEGIN {
#define PHASE_END   if (ph == 0) grid.sync(); else if (ph + 1 < N_PHASES) xcd_barrier(bar); } ++ph;

    PHASE_BEGIN
        weights_phase(p, lds);
        row_pass<false, true>(p.x, nullptr, nullptr, nullptr, p.norms, XB, T);
        for (int l = 0; l < DEPTH; ++l) row_pass<false, true>(p.mem, nullptr, nullptr, nullptr, p.mem_norm + l * DM, MEMN + (size_t)l * 4096 * DM, BATCH * MEML);
        __syncthreads();
    PHASE_END

    for (int l = 0; l < DEPTH; ++l) {
        const unsigned char* wl = ws + WS_W + (size_t)l * W_LAYER;
        const float* nl = p.norms + (size_t)l * 6 * DM;
        const float* xin = (l == 0) ? p.x : p.out;
        PHASE_BEGIN
            run_gemm(lds, XB, (const bf16*)(wl + WO_IN), T, PROJ_LD, DM, pg8::EpiStoreBf16{PROJ, PROJ_LD, 2, nsa::QSCALE});
            run_gemm(lds, MEMN + (size_t)l * 4096 * DM, (const bf16*)(wl + WO_KV), BATCH * MEML, 512, DM, pg8::EpiStoreBf16{MEMKV + (size_t)l * 4096 * 512, 512, 0, 1.f});
        PHASE_END
        PHASE_BEGIN
            for (int it = blockIdx.x; it < BATCH * 127; it += G) compress_item(p, l, it, lds);
        PHASE_END
        PHASE_BEGIN
#ifdef NSA_NAIVE
            for (int it = blockIdx.x; it < BATCH * 32; it += G) nsa_item(p, l, (it & ~31) | (it < 256 ? 31 - (it & 31) : (it & 31)), lds);
#else
            nsa::build_tables(p.rel_bias, lds, opaque_tid());
            for (int it = blockIdx.x; it < BATCH * 32; it += G) nsa_item_mfma(p, l, (it & ~31) | (it < 256 ? 31 - (it & 31) : (it & 31)), lds);
#endif
        PHASE_END
        PHASE_BEGIN
            run_gemm(lds, XB, (const bf16*)(wl + WO_OUT), T, DM, DM, pg8::EpiStoreF32{H, DM});
        PHASE_END
        PHASE_BEGIN
            row_pass<true, true>(xin, H, nl + DM, p.out, nl + 2 * DM, XB, T);
        PHASE_END
        PHASE_BEGIN
            run_gemm(lds, XB, (const bf16*)(wl + WO_Q), T, 256, DM, pg8::EpiStoreBf16{QM, 256, 1, nsa::QSCALE});
        PHASE_END
        PHASE_BEGIN
            for (int it = blockIdx.x; it < BATCH * 32; it += G) memattn_unit(p, l, it, lds);
        PHASE_END
        PHASE_BEGIN
            run_gemm(lds, OM, (const bf16*)(wl + WO_O), T, DM, 256, pg8::EpiStoreF32{H, DM});
        PHASE_END
        PHASE_BEGIN
            row_pass<true, true>(p.out, H, nl + 3 * DM, p.out, nl + 4 * DM, XB, T);
        PHASE_END
        PHASE_BEGIN
            run_gemm(lds, XB, (const bf16*)(wl + WO_GU), T, 2 * FFN, DM, pg8::EpiSwiGLU{HID, FFN});
        PHASE_END
        PHASE_BEGIN
            run_gemm(lds, HID, (const bf16*)(wl + WO_D), T, DM, FFN, pg8::EpiStoreF32{H, DM});
        PHASE_END
        PHASE_BEGIN
            if (l + 1 < DEPTH) row_pass<true, true>(p.out, H, nl + 5 * DM, p.out, nl + 6 * DM, XB, T);
            else row_pass<true, false>(p.out, H, nl + 5 * DM, p.out, nullptr, nullptr, T);
        PHASE_END
    }
}

extern "C" void kernel_launch(void* const* d_in, const int* in_sizes, int n_in, void* d_out, int out_size, void* d_ws, size_t ws_size, hipStream_t stream) {
    static int grid = 0;
    if (grid == 0) {
        if (n_in != 21 || in_sizes[0] != T * DM || out_size != T * DM || ws_size < WS_END) { fprintf(stderr, "kernel_launch: unexpected problem (n_in %d, in0 %d, out %d, ws %zu < %zu)\n", n_in, n_in > 0 ? in_sizes[0] : -1, out_size, ws_size, (size_t)WS_END); grid = -1; return; }
        int dev = 0, cus = 0, per_cu = 0;
        if (hipGetDevice(&dev) != hipSuccess || hipDeviceGetAttribute(&cus, hipDeviceAttributeMultiprocessorCount, dev) != hipSuccess) { grid = -1; return; }
        if (hipFuncSetAttribute((const void*)hymba_fwd, hipFuncAttributeMaxDynamicSharedMemorySize, LDS_BYTES) != hipSuccess) { fprintf(stderr, "kernel_launch: hipFuncSetAttribute failed\n"); grid = -1; return; }
        if (hipOccupancyMaxActiveBlocksPerMultiprocessor(&per_cu, (const void*)hymba_fwd, NTHREADS, LDS_BYTES) != hipSuccess || per_cu < 1) { fprintf(stderr, "kernel_launch: occupancy query says %d blocks per CU\n", per_cu); grid = -1; return; }
        grid = cus;
    }
    if (grid < 0) return;
    Params p{};
    const float** fp = (const float**)&p;
    for (int i = 0; i < 21; ++i) fp[i] = (const float*)d_in[i];
    p.out = (float*)d_out; p.ws = (unsigned char*)d_ws;
    if (hipMemsetAsync((char*)d_ws + WS_CTL, 0, CTL_ZERO_BYTES, stream) != hipSuccess) { fprintf(stderr, "kernel_launch: hipMemsetAsync failed\n"); return; }
    { void* args[] = {&p};
      hipError_t e = hipLaunchCooperativeKernel((void*)hymba_fwd, dim3(grid), dim3(NTHREADS), args, LDS_BYTES, stream);
      if (e != hipSuccess) fprintf(stderr, "cooperative launch failed: %s (grid %d)\n", hipGetErrorString(e), grid); }
}
```

```cpp
#include <hip/hip_runtime.h>
#include <hip/hip_cooperative_groups.h>
#include <cstdio>
#include <cstdint>
namespace cg = cooperative_groups;
namespace pg8 {
#define PG8_LAS __attribute__((address_space(3)))
typedef unsigned short bf16_t;
typedef short bf16x8 __attribute__((ext_vector_type(8)));
typedef float f32x4 __attribute__((ext_vector_type(4)));
typedef unsigned u32x4 __attribute__((ext_vector_type(4)));
constexpr int BM = 256, BK = 64, HALF = 128, HTB = HALF * BK * 2  , STAGE_BYTES = 8 * HTB, NXCD = 8, WGM = 8;

__host__ __device__ __forceinline__ int lds_byte(int r, int c) { const int st = (r >> 4) * 2 + (c >> 5), rr = r & 15, cc = c & 31, ob = rr * 64 + cc * 2; return st * 1024 + (ob ^ (((ob >> 9) & 1) << 5)); }
__host__ __device__ __forceinline__ void stage_rc(int b, int& R, int& C) { const int st = b / 1024, sb = b % 1024, swz = sb ^ (((sb >> 9) & 1) << 5); R = (st >> 1) * 16 + swz / 64; C = (st & 1) * 32 + (swz % 64) / 2; }
__host__ __device__ __forceinline__ int perm32(int rho) { const int n = rho >> 4, i = rho & 15; return 8 * (i >> 2) + 4 * n + (i & 3); }

struct Unit { int pm, pn; };
struct Gemm { const bf16_t* A; const bf16_t* Bt; int M, N, K, lda; };

struct StaticOrder {
    int nM, nN, nwg, G, c;
    __host__ __device__ void init(int M, int N, int G_, int c_) { nM = M / BM; nN = N / BM; nwg = nM * nN; G = G_; c = c_; }
    __host__ __device__ bool next(int i, Unit& u) const {
        const long L = (long)i * G + c; if (L >= nwg) return false;
        int wgid = (int)L; { const int q = nwg / NXCD, r = nwg % NXCD, xcd = wgid % NXCD, off = wgid / NXCD; wgid = (xcd < r ? xcd * (q + 1) : r * (q + 1) + (xcd - r) * q) + off; }
        const int nig = WGM * nN, gid = wgid / nig, fm = gid * WGM, gsz = (nM - fm) < WGM ? (nM - fm) : WGM;
        u.pm = fm + ((wgid % nig) % gsz); u.pn = (wgid % nig) / gsz; return true;
    }
    __device__ __forceinline__ void a_ready(const Unit&) const {}
    __device__ __forceinline__ void done(const Unit&) const {}
};

__device__ __forceinline__ unsigned cvt_pk_bf16(float lo, float hi) { unsigned r; asm volatile("v_cvt_pk_bf16_f32 %0, %1, %2" : "=v"(r) : "v"(lo), "v"(hi)); return r; }
typedef float f32x2 __attribute__((ext_vector_type(2)));
struct EpiStoreBf16 {
    static constexpr bool PERM = true, AFTER_DRAIN = false;
    bf16_t* O; int ldc; int scale_tiles; float scale;
    bf16_t* R; int rtile;
    __device__ __forceinline__ void operator()(const f32x4 (&acc)[2][2][4][2], const Unit& u, int wr, int wc, int fr, int fq) const {
        const int row0 = u.pm * BM + wr * 64 + fr, col0 = u.pn * BM + wc * 32 + 8 * fq; const float sc = u.pn < scale_tiles ? scale : 1.f;
#pragma unroll
        for (int ai = 0; ai < 2; ++ai)
#pragma unroll
            for (int m = 0; m < 4; ++m) { const int row = row0 + ai * HALF + m * 16; bf16_t* rowp = O + (size_t)row * ldc + col0;
#pragma unroll
                for (int bj = 0; bj < 2; ++bj) { const f32x4 v0 = acc[ai][bj][m][0] * sc, v1 = acc[ai][bj][m][1] * sc;
                    u32x4 w; w.x = cvt_pk_bf16(v0[0], v0[1]); w.y = cvt_pk_bf16(v0[2], v0[3]); w.z = cvt_pk_bf16(v1[0], v1[1]); w.w = cvt_pk_bf16(v1[2], v1[3]);
                    if (u.pn == rtile) { const int c64 = wc * 32 + 8 * fq; *(u32x4*)(R + ((size_t)((bj * 16 + (row >> 11)) * 2 + (c64 >> 6)) * 2048 + (row & 2047)) * 64 + (c64 & 63)) = w; }
                    else *(u32x4*)(rowp + bj * HALF) = w; } }
    }
};
struct EpiStoreF32 {
    static constexpr bool PERM = true, AFTER_DRAIN = false;
    float* O; int ldc;
    __device__ __forceinline__ void operator()(const f32x4 (&acc)[2][2][4][2], const Unit& u, int wr, int wc, int fr, int fq) const {
        const int row0 = u.pm * BM + wr * 64 + fr, col0 = u.pn * BM + wc * 32 + 8 * fq;
#pragma unroll
        for (int ai = 0; ai < 2; ++ai)
#pragma unroll
            for (int m = 0; m < 4; ++m) { float* rowp = O + (size_t)(row0 + ai * HALF + m * 16) * ldc + col0;
#pragma unroll
                for (int bj = 0; bj < 2; ++bj) { *(f32x4*)(rowp + bj * HALF) = acc[ai][bj][m][0]; *(f32x4*)(rowp + bj * HALF + 4) = acc[ai][bj][m][1]; } }
    }
};
struct EpiSwiGLU {
    static constexpr bool PERM = true, AFTER_DRAIN = false;
    bf16_t* O; int ldc;
    __device__ __forceinline__ void operator()(const f32x4 (&acc)[2][2][4][2], const Unit& u, int wr, int wc, int fr, int fq) const {
        const int row0 = u.pm * BM + wr * 64 + fr, col0 = u.pn * HALF + wc * 32 + 8 * fq;
#pragma unroll
        for (int ai = 0; ai < 2; ++ai)
#pragma unroll
            for (int m = 0; m < 4; ++m) { bf16_t* rowp = O + (size_t)(row0 + ai * HALF + m * 16) * ldc + col0;
                float h[8];
#pragma unroll
                for (int n = 0; n < 2; ++n)
#pragma unroll
                    for (int i = 0; i < 4; ++i) { const float g = acc[ai][0][m][n][i], up = acc[ai][1][m][n][i]; h[4 * n + i] = g * up / (1.0f + __expf(-g)); }
                u32x4 w; w.x = cvt_pk_bf16(h[0], h[1]); w.y = cvt_pk_bf16(h[2], h[3]); w.z = cvt_pk_bf16(h[4], h[5]); w.w = cvt_pk_bf16(h[6], h[7]);
                *(u32x4*)rowp = w; }
    }
};

template <int SEL> struct EpiCompress {
    static constexpr bool PERM = true, AFTER_DRAIN = true;
    const float* cbias; const float* w2; bf16_t* dst;
    __device__ __forceinline__ void fused(f32x4 (&acc)[2][2][4][2], const Unit& u, int wr, int wc, int fr, int fq, PG8_LAS unsigned char* lds, int wid, int lane) const {
        constexpr int HROW = 272;
        PG8_LAS float* W2 = (PG8_LAS float*)lds; PG8_LAS unsigned char* HID = lds + 32768;
        const int tid = wid * 64 + lane;
        for (int i = tid; i < 128 * 64 / 4; i += 512) ((PG8_LAS f32x4*)W2)[i] = ((const f32x4*)w2)[i];
        const int colb = wc * 32 + 8 * fq; const f32x4 cb0 = *(const f32x4*)(cbias + colb), cb1 = *(const f32x4*)(cbias + colb + 4);
#pragma unroll
        for (int ai = 0; ai < 2; ++ai)
#pragma unroll
            for (int m = 0; m < 4; ++m) { const int row = ai * HALF + wr * 64 + m * 16 + fr; f32x4 v0 = acc[ai][SEL][m][0] + cb0, v1 = acc[ai][SEL][m][1] + cb1; float hv[8];
#pragma unroll
                for (int i = 0; i < 4; ++i) { const float x0 = v0[i], x1 = v1[i];
                    hv[i] = x0 / (1.0f + __expf(-1.5957691216057308f * (x0 + 0.044715f * x0 * x0 * x0))); hv[4 + i] = x1 / (1.0f + __expf(-1.5957691216057308f * (x1 + 0.044715f * x1 * x1 * x1))); }
                u32x4 w; w.x = cvt_pk_bf16(hv[0], hv[1]); w.y = cvt_pk_bf16(hv[2], hv[3]); w.z = cvt_pk_bf16(hv[4], hv[5]); w.w = cvt_pk_bf16(hv[6], hv[7]);
                *(PG8_LAS u32x4*)(HID + row * HROW + colb * 2) = w; }
        asm volatile("s_waitcnt lgkmcnt(0)" ::: "memory"); __builtin_amdgcn_s_barrier(); asm volatile("" ::: "memory");
        const int row = tid >> 1, eh = tid & 1; float a[32];
#pragma unroll
        for (int i = 0; i < 32; ++i) a[i] = 0.f;
#pragma unroll 2
        for (int j = 0; j < 128; ++j) { const float hvv = __uint_as_float((unsigned)*(const PG8_LAS unsigned short*)(HID + row * HROW + j * 2) << 16);
            const PG8_LAS f32x4* wrow = (const PG8_LAS f32x4*)(W2 + j * 64 + 32 * eh);
#pragma unroll
            for (int e4 = 0; e4 < 8; ++e4) { const f32x4 wv = wrow[e4]; a[4 * e4] += hvv * wv[0]; a[4 * e4 + 1] += hvv * wv[1]; a[4 * e4 + 2] += hvv * wv[2]; a[4 * e4 + 3] += hvv * wv[3]; } }
        bf16_t* o = dst + (size_t)(u.pm * BM + row) * 64 + 32 * eh;
#pragma unroll
        for (int c = 0; c < 4; ++c) { u32x4 w; w.x = cvt_pk_bf16(a[8 * c], a[8 * c + 1]); w.y = cvt_pk_bf16(a[8 * c + 2], a[8 * c + 3]); w.z = cvt_pk_bf16(a[8 * c + 4], a[8 * c + 5]); w.w = cvt_pk_bf16(a[8 * c + 6], a[8 * c + 7]); *(u32x4*)(o + 8 * c) = w; }
        asm volatile("s_waitcnt lgkmcnt(0)" ::: "memory"); __builtin_amdgcn_s_barrier(); asm volatile("" ::: "memory");
    }
};
template <class Epi, class Sched, bool ALIGN_EPI = false, bool SP2 = false>
__device__ __forceinline__ void gemm_phase(PG8_LAS unsigned char* lds, const Gemm g, const Sched& S, const Epi& E, const int wv) {
    int tid_raw; { unsigned ones = ~0u; asm volatile("" : "+s"(ones)); tid_raw = __builtin_amdgcn_mbcnt_hi(ones, __builtin_amdgcn_mbcnt_lo(ones, 0u)) + 64 * wv; }
    const int tid = tid_raw, wid = wv, lane = tid & 63, wr = wid >> 2, wc = wid & 3, fr = lane & 15, fq = lane >> 4;
    const int K = g.K, nt = K / BK;
    unsigned voffA[2], voffB[2];
#pragma unroll
    for (int i = 0; i < 2; ++i) { int R, C; stage_rc(tid * 16 + i * 8192, R, C); const int Rb = Epi::PERM ? ((R & ~31) + perm32(R & 31)) : R;
        voffA[i] = (unsigned)(R * g.lda + C) * 2u; voffB[i] = (unsigned)(Rb * K + C) * 2u; }
    const size_t kstep = (size_t)(BK * 2);
    const size_t hstep = (size_t)HALF * K * 2;
    const size_t tstep = 2 * hstep;
    const size_t hstepA = (size_t)HALF * g.lda * 2, tstepA = 2 * hstepA;
    const unsigned ldsw = (unsigned)wid * 1024u;
    const int aoff = lds_byte(wr * 64 + fr, fq * 8), boff = lds_byte(wc * 32 + fr, fq * 8);
#define PG8_SA(b, h) (((b) * 2 + (h)) * HTB)
#define PG8_SB(b, h) ((4 + (b) * 2 + (h)) * HTB)
#define PG8_STAGE(bufoff, gbase, voff) do { _Pragma("unroll") for (int _i = 0; _i < 2; ++_i) \
        __builtin_amdgcn_global_load_lds((const unsigned*)((const char*)(gbase) + (voff)[_i]), (PG8_LAS unsigned*)(lds + (bufoff) + ldsw + _i * 8192), 16, 0, 0); } while (0)
#define PG8_LDA(dst, b, h) do { _Pragma("unroll") for (int m = 0; m < 4; ++m) _Pragma("unroll") for (int k = 0; k < 2; ++k) dst[m][k] = *(const PG8_LAS bf16x8*)(lds + PG8_SA(b, h) + aoff + m * 2048 + k * 1024); } while (0)
#define PG8_LDB(dst, b, h) do { _Pragma("unroll") for (int n = 0; n < 2; ++n) _Pragma("unroll") for (int k = 0; k < 2; ++k) dst[n][k] = *(const PG8_LAS bf16x8*)(lds + PG8_SB(b, h) + boff + n * 2048 + k * 1024); } while (0)
#define PG8_MMA(ai, bj, At, Bt) do { __builtin_amdgcn_s_setprio(1); _Pragma("unroll") for (int m = 0; m < 4; ++m) _Pragma("unroll") for (int n = 0; n < 2; ++n) _Pragma("unroll") for (int k = 0; k < 2; ++k) \
        acc[ai][bj][m][n] = __builtin_amdgcn_mfma_f32_16x16x32_bf16(Bt[n][k], At[m][k], acc[ai][bj][m][n], 0, 0, 0); __builtin_amdgcn_s_setprio(0); } while (0)
#define PG8_WAIT_V(n) asm volatile("s_waitcnt vmcnt(" #n ")" ::: "memory")
#define PG8_WAIT_L(n) asm volatile("s_waitcnt lgkmcnt(" #n ")" ::: "memory")
#define PG8_BAR __builtin_amdgcn_s_barrier()
#define PG8_SCHED __builtin_amdgcn_sched_barrier(0)
    Unit cur, nxt; int ui = 0;
    if (!S.next(0, cur)) return;
    f32x4 acc[2][2][4][2];
#pragma unroll
    for (int a = 0; a < 2; ++a)
#pragma unroll
        for (int b = 0; b < 2; ++b)
#pragma unroll
            for (int m = 0; m < 4; ++m)
#pragma unroll
                for (int n = 0; n < 2; ++n) acc[a][b][m][n] = (f32x4){0.f, 0.f, 0.f, 0.f};
    bf16x8 At[4][2], B0[2][2], B1[2][2];
    const char* cA = (const char*)g.A + (size_t)cur.pm * tstepA; const char* cB = (const char*)g.Bt + (size_t)cur.pn * tstep;
    S.a_ready(cur);
    if constexpr (SP2) {
        PG8_STAGE(PG8_SB(0, 0), cB, voffB); PG8_STAGE(PG8_SB(0, 1), cB + hstep, voffB); PG8_STAGE(PG8_SA(0, 0), cA, voffA); PG8_STAGE(PG8_SA(0, 1), cA + hstepA, voffA);
        if (wr == 1) PG8_BAR;
        PG8_WAIT_V(2); PG8_BAR;
        PG8_STAGE(PG8_SB(1, 0), cB + kstep, voffB); PG8_STAGE(PG8_SA(1, 0), cA + kstep, voffA); PG8_STAGE(PG8_SB(1, 1), cB + hstep + kstep, voffB);
        PG8_WAIT_V(6); PG8_BAR;
    } else {
        PG8_STAGE(PG8_SB(0, 0), cB, voffB); PG8_STAGE(PG8_SA(0, 0), cA, voffA); PG8_STAGE(PG8_SB(0, 1), cB + hstep, voffB); PG8_STAGE(PG8_SA(0, 1), cA + hstepA, voffA);
        if (wr == 1) PG8_BAR;
        PG8_WAIT_V(4); PG8_BAR;
        PG8_STAGE(PG8_SB(1, 0), cB + kstep, voffB); PG8_STAGE(PG8_SA(1, 0), cA + kstep, voffA); PG8_STAGE(PG8_SB(1, 1), cB + hstep + kstep, voffB);
        PG8_WAIT_V(6); PG8_BAR;
    }
    for (;;) {
        const bool has_next = S.next(ui + 1, nxt);
        const char* nA = has_next ? (const char*)g.A + (size_t)nxt.pm * tstepA : cA; const char* nB = has_next ? (const char*)g.Bt + (size_t)nxt.pn * tstep : cB;
        for (int t = 0; t < nt; t += 2) {
            const bool last = (t == nt - 2);
            const char* a1 = cA + (size_t)(t + 1) * kstep;
            const char* a2 = last ? nA : cA + (size_t)(t + 2) * kstep; const char* b2 = last ? nB : cB + (size_t)(t + 2) * kstep;
            const char* a3 = a2 + kstep; const char* b3 = b2 + kstep;
            if (last && has_next) S.a_ready(nxt);
            if constexpr (SP2) {
            PG8_LDB(B0, 0, 0); PG8_LDB(B1, 0, 1); PG8_SCHED; PG8_LDA(At, 0, 0); PG8_STAGE(PG8_SA(1, 1), a1 + hstepA, voffA);
            PG8_WAIT_V(8); PG8_WAIT_L(0); PG8_BAR; PG8_MMA(0, 0, At, B0); PG8_MMA(0, 1, At, B1); PG8_BAR; PG8_SCHED;
            PG8_LDA(At, 0, 1); PG8_STAGE(PG8_SB(0, 0), b2, voffB); PG8_STAGE(PG8_SB(0, 1), b2 + hstep, voffB); PG8_STAGE(PG8_SA(0, 0), a2, voffA);
            PG8_WAIT_V(8); PG8_WAIT_L(0); PG8_BAR; PG8_MMA(1, 0, At, B0); PG8_MMA(1, 1, At, B1); PG8_BAR; PG8_SCHED;
            PG8_LDB(B0, 1, 0); PG8_LDB(B1, 1, 1); PG8_SCHED; PG8_LDA(At, 1, 0); PG8_STAGE(PG8_SA(0, 1), a2 + hstepA, voffA);
            PG8_WAIT_V(8); PG8_WAIT_L(0); PG8_BAR; PG8_MMA(0, 0, At, B0); PG8_MMA(0, 1, At, B1); PG8_BAR; PG8_SCHED;
            PG8_LDA(At, 1, 1); PG8_STAGE(PG8_SB(1, 0), b3, voffB); PG8_STAGE(PG8_SB(1, 1), b3 + hstep, voffB); PG8_STAGE(PG8_SA(1, 0), a3, voffA);
            PG8_WAIT_V(8); PG8_WAIT_L(0); PG8_BAR; PG8_MMA(1, 0, At, B0); PG8_MMA(1, 1, At, B1); PG8_BAR; PG8_SCHED;
            } else {
            PG8_LDB(B0, 0, 0); PG8_SCHED; PG8_LDA(At, 0, 0); PG8_STAGE(PG8_SA(1, 1), a1 + hstepA, voffA);
            PG8_WAIT_L(8); PG8_BAR; PG8_WAIT_L(0); PG8_MMA(0, 0, At, B0); PG8_BAR; PG8_SCHED;
            PG8_LDB(B1, 0, 1); PG8_STAGE(PG8_SB(0, 0), b2, voffB);
            PG8_BAR; PG8_WAIT_L(0); PG8_MMA(0, 1, At, B1); PG8_BAR;
            PG8_LDA(At, 0, 1); PG8_STAGE(PG8_SA(0, 0), a2, voffA);
            PG8_BAR; PG8_WAIT_L(0); PG8_MMA(1, 0, At, B0); PG8_BAR; PG8_SCHED;
            PG8_STAGE(PG8_SB(0, 1), b2 + hstep, voffB);
            PG8_WAIT_V(6); PG8_BAR; PG8_MMA(1, 1, At, B1); PG8_BAR;
            PG8_LDB(B0, 1, 0); PG8_SCHED; PG8_LDA(At, 1, 0); PG8_STAGE(PG8_SA(0, 1), a2 + hstepA, voffA);
            PG8_WAIT_L(8); PG8_BAR; PG8_WAIT_L(0); PG8_MMA(0, 0, At, B0); PG8_BAR; PG8_SCHED;
            PG8_LDB(B1, 1, 1); PG8_STAGE(PG8_SB(1, 0), b3, voffB);
            PG8_BAR; PG8_WAIT_L(0); PG8_MMA(0, 1, At, B1); PG8_BAR;
            PG8_LDA(At, 1, 1); PG8_STAGE(PG8_SA(1, 0), a3, voffA);
            PG8_BAR; PG8_WAIT_L(0); PG8_MMA(1, 0, At, B0); PG8_BAR; PG8_SCHED;
            PG8_STAGE(PG8_SB(1, 1), b3 + hstep, voffB);
            PG8_WAIT_V(6); PG8_BAR; PG8_MMA(1, 1, At, B1); PG8_BAR;
            }
        }
        if constexpr (ALIGN_EPI) { if (wr == 0) PG8_BAR; }
        if constexpr (!Epi::AFTER_DRAIN) { E(acc, cur, wr, wc, fr, fq); S.done(cur); }
        if (!has_next) break;
#pragma unroll
        for (int a = 0; a < 2; ++a)
#pragma unroll
            for (int b = 0; b < 2; ++b)
#pragma unroll
                for (int m = 0; m < 4; ++m)
#pragma unroll
                    for (int n = 0; n < 2; ++n) acc[a][b][m][n] = (f32x4){0.f, 0.f, 0.f, 0.f};
        cur = nxt; cA = nA; cB = nB; ++ui;
        if constexpr (ALIGN_EPI) { if (wr == 1) PG8_BAR; }
    }
    PG8_WAIT_V(0);
    if constexpr (!ALIGN_EPI) { if (wr == 0) PG8_BAR; }
    PG8_BAR;
    if constexpr (Epi::AFTER_DRAIN) { E.fused(acc, cur, wr, wc, fr, fq, lds, wid, lane); S.done(cur); }
#undef PG8_SA
#undef PG8_SB
#undef PG8_STAGE
#undef PG8_LDA
#undef PG8_LDB
#undef PG8_MMA
#undef PG8_WAIT_V
#undef PG8_WAIT_L
#undef PG8_BAR
#undef PG8_SCHED
}
}
#define LAS __attribute__((address_space(3)))
typedef unsigned short bf16;
typedef unsigned u32x4 __attribute__((ext_vector_type(4)));
typedef float f32x4 __attribute__((ext_vector_type(4)));
constexpr int BATCH = 16, SEQ = 2048, DM = 1024, T = BATCH * SEQ, DEPTH = 2;
constexpr int IN_W = 2840, PROJ_LD = 3072, FFN = 2816, MEML = 256;
constexpr int CQ = 0, CKC = 512, CVC = 640, CKS = 768, CVS = 896, CKW = 1024, CVW = 1152, CCB = 1280, CCC = 1792, CCX = 2304, CGL = 2816;
constexpr float RMS_EPS = 1e-6f;
constexpr int NWAVES = 8, NTHREADS = 512;
constexpr int LDS_BYTES = 147456, MISC_OFF = 131072 + 320;
constexpr int N_PHASES = 1 + 2 * 12;
constexpr size_t WS_CTL = 0; constexpr int CW_BAR = 4096, CTL_ZERO_BYTES = 65536;
constexpr size_t MiB = 1u << 20;
constexpr size_t WS_W = 1 * MiB, W_LAYER = 28 * MiB;
constexpr size_t WO_IN = 0, WO_OUT = 6 * MiB, WO_Q = 8 * MiB, WO_KV = 8 * MiB + 512 * 1024, WO_O = 9 * MiB + 512 * 1024, WO_GU = 10 * MiB, WO_D = 21 * MiB, WO_C1 = 27 * MiB;
constexpr size_t WS_MEMN = 57 * MiB, WS_MEMKV = 73 * MiB, WS_KCMP = 81 * MiB, WS_VCMP = 82 * MiB, WS_CBIAS = 83 * MiB, WS_QM = 84 * MiB, WS_OM = 100 * MiB, WS_XB = 116 * MiB, WS_H = 180 * MiB, WS_PROJ = 308 * MiB, WS_END = 500 * MiB;
constexpr size_t WS_KC2 = WS_QM;

__device__ const int T5_BUCKET[128] = {0,1,2,3,4,5,6,7,8,9,10,11,12,13,14,15,16,16,16,17,17,18,18,18,19,19,19,20,20,20,20,21,21,21,21,22,22,22,22,22,23,23,23,23,23,23,24,24,24,24,24,24,25,25,25,25,25,25,25,26,26,26,26,26,26,26,26,27,27,27,27,27,27,27,27,27,27,28,28,28,28,28,28,28,28,28,28,29,29,29,29,29,29,29,29,29,29,29,29,30,30,30,30,30,30,30,30,30,30,30,30,30,30,31,31,31,31,31,31,31,31,31,31,31,31,31,31,31};

struct Params {
    const float *x, *mem, *rel_bias, *norms, *mem_norm, *gn_nsa, *gn_conv, *w_in, *w_out, *cmp_pe, *ck1, *ck2, *cv1, *cv2, *conv_w, *mem_wq, *mem_wkv, *mem_wo, *ffn_wg, *ffn_wu, *ffn_wd;
    float* out; unsigned char* ws;
};

__device__ __forceinline__ unsigned f2bf(float f) { unsigned u = __builtin_bit_cast(unsigned, f); return (u + 0x7fffu + ((u >> 16) & 1u)) >> 16; }
__device__ __forceinline__ unsigned pk2(float lo, float hi) { return f2bf(lo) | (f2bf(hi) << 16); }
__device__ __forceinline__ float bflo(unsigned u) { return __uint_as_float(u << 16); }
__device__ __forceinline__ float bfhi(unsigned u) { return __uint_as_float(u & 0xffff0000u); }
template <int CTRL> __device__ __forceinline__ float dppf(float x) { return __builtin_bit_cast(float, __builtin_amdgcn_update_dpp(0, __builtin_bit_cast(int, x), CTRL, 0xf, 0xf, true)); }
template <int PAT> __device__ __forceinline__ float swzf(float x) { return __builtin_bit_cast(float, __builtin_amdgcn_ds_swizzle(__builtin_bit_cast(int, x), PAT)); }
__device__ __forceinline__ float xor1f(float x) { return dppf<0xB1>(x); }
__device__ __forceinline__ float xor2f(float x) { return dppf<0x4E>(x); }
__device__ __forceinline__ float xor4f(float x) { return swzf<0x101F>(x); }
__device__ __forceinline__ float xor8f(float x) { return swzf<0x201F>(x); }
__device__ __forceinline__ float xor16f(float x) { return swzf<0x401F>(x); }
__device__ __forceinline__ float half_sum(float x) { auto rr = __builtin_amdgcn_permlane32_swap(__float_as_uint(x), __float_as_uint(x), false, false); return __uint_as_float(rr[0]) + __uint_as_float(rr[1]); }
__device__ __forceinline__ float half_max(float x) { auto rr = __builtin_amdgcn_permlane32_swap(__float_as_uint(x), __float_as_uint(x), false, false); return fmaxf(__uint_as_float(rr[0]), __uint_as_float(rr[1])); }
__device__ __forceinline__ float wave_sum(float v) { v += xor1f(v); v += xor2f(v); v += xor4f(v); v += xor8f(v); v += xor16f(v); return half_sum(v); }
#define LDS_WAIT() asm volatile("s_waitcnt lgkmcnt(0)" ::: "memory")
__device__ __forceinline__ int opaque_lane() { unsigned ones = ~0u; asm volatile("" : "+s"(ones)); return __builtin_amdgcn_mbcnt_hi(ones, __builtin_amdgcn_mbcnt_lo(ones, 0u)); }
__device__ __forceinline__ int opaque_bid() { int b = blockIdx.x; asm volatile("" : "+s"(b)); return b; }
__device__ __forceinline__ int opaque_tid(int wv) { return opaque_lane() + 64 * wv; }

__device__ __forceinline__ void transpose_item(const float* W, int N, bf16* WT, int ldk, int k0, int nsrc, int ndst, int nvalid, LAS float* scr, int lane) {
    const int n_ = lane & 31;
#pragma unroll 8
    for (int i = 0; i < 32; ++i) { const int kk = 2 * i + (lane >> 5); scr[kk * 33 + n_] = (n_ < nvalid) ? W[(size_t)(k0 + kk) * N + nsrc + n_] : 0.f; }
    LDS_WAIT(); asm volatile("" ::: "memory");
    const int c = lane & 7;
#pragma unroll
    for (int j = 0; j < 4; ++j) { const int n = (lane >> 3) + 8 * j; const LAS float* s = scr + (8 * c) * 33 + n;
        u32x4 o; o.x = pk2(s[0 * 33], s[1 * 33]); o.y = pk2(s[2 * 33], s[3 * 33]); o.z = pk2(s[4 * 33], s[5 * 33]); o.w = pk2(s[6 * 33], s[7 * 33]);
        *(u32x4*)(WT + (size_t)(ndst + n) * ldk + k0 + 8 * c) = o; }
    LDS_WAIT(); asm volatile("" ::: "memory");
}
__device__ __forceinline__ void weights_phase(const Params& p, LAS unsigned char* lds, int wv) {
    const int tid = opaque_tid(wv), lane = tid & 63, wave = wv, gw = opaque_bid() * NWAVES + wave, NGW = gridDim.x * NWAVES;
    LAS float* scr = (LAS float*)(lds + wave * 16384);
    constexpr int I_IN = 16 * 96, I_OUT = 16 * 32, I_Q = 16 * 8, I_KV = 16 * 16, I_O = 4 * 32, I_G = 16 * 88, I_D = 44 * 32;
    constexpr int I_C = 32 * 4;
    constexpr int PER_LAYER = I_IN + I_OUT + I_Q + I_KV + I_O + 2 * I_G + I_D + 2 * I_C;
    for (int it = gw; it < DEPTH * PER_LAYER; it += NGW) {
        const int l = it / PER_LAYER; int r = it % PER_LAYER;
        unsigned char* wl = p.ws + WS_W + (size_t)l * W_LAYER;
        if (r < I_IN) { const int kb = r / 96, db = r % 96, ndst = 32 * db; int nsrc, nv;
            if (ndst < 1280) { nsrc = ndst; nv = 32; } else if (ndst < 2816) { nsrc = ndst + 24; nv = 32; } else if (ndst == 2816) { nsrc = 1280; nv = 24; } else { nsrc = 0; nv = 0; }
            transpose_item(p.w_in + (size_t)l * DM * IN_W, IN_W, (bf16*)(wl + WO_IN), DM, 64 * kb, nsrc, ndst, nv, scr, lane); continue; } r -= I_IN;
        if (r < I_OUT) { const int kb = r / 32, nb = r % 32; transpose_item(p.w_out + (size_t)l * DM * DM, DM, (bf16*)(wl + WO_OUT), DM, 64 * kb, 32 * nb, 32 * nb, 32, scr, lane); continue; } r -= I_OUT;
        if (r < I_Q) { const int kb = r / 8, nb = r % 8; transpose_item(p.mem_wq + (size_t)l * DM * 256, 256, (bf16*)(wl + WO_Q), DM, 64 * kb, 32 * nb, 32 * nb, 32, scr, lane); continue; } r -= I_Q;
        if (r < I_KV) { const int kb = r / 16, nb = r % 16; transpose_item(p.mem_wkv + (size_t)l * DM * 512, 512, (bf16*)(wl + WO_KV), DM, 64 * kb, 32 * nb, 32 * nb, 32, scr, lane); continue; } r -= I_KV;
        if (r < I_O) { const int kb = r / 32, nb = r % 32; transpose_item(p.mem_wo + (size_t)l * 256 * DM, DM, (bf16*)(wl + WO_O), 256, 64 * kb, 32 * nb, 32 * nb, 32, scr, lane); continue; } r -= I_O;
        if (r < I_G) { const int kb = r / 88, nb = r % 88; transpose_item(p.ffn_wg + (size_t)l * DM * FFN, FFN, (bf16*)(wl + WO_GU), DM, 64 * kb, 32 * nb, 256 * (nb >> 2) + 32 * (nb & 3), 32, scr, lane); continue; } r -= I_G;
        if (r < I_G) { const int kb = r / 88, nb = r % 88; transpose_item(p.ffn_wu + (size_t)l * DM * FFN, FFN, (bf16*)(wl + WO_GU), DM, 64 * kb, 32 * nb, 256 * (nb >> 2) + 128 + 32 * (nb & 3), 32, scr, lane); continue; } r -= I_G;
        if (r < I_D) { const int kb = r / 32, nb = r % 32; transpose_item(p.ffn_wd + (size_t)l * FFN * DM, DM, (bf16*)(wl + WO_D), FFN, 64 * kb, 32 * nb, 32 * nb, 32, scr, lane); continue; } r -= I_D;
        if (r < I_C) { const int kb = r / 4, nb = r % 4; transpose_item(p.ck1 + (size_t)l * 2048 * 128, 128, (bf16*)(wl + WO_C1), 2048, 64 * kb, 32 * nb, 32 * nb, 32, scr, lane); continue; } r -= I_C;
        { const int kb = r / 4, nb = r % 4; transpose_item(p.cv1 + (size_t)l * 2048 * 128, 128, (bf16*)(wl + WO_C1), 2048, 64 * kb, 32 * nb, 128 + 32 * nb, 32, scr, lane); }
    }
    for (int it = gw; it < DEPTH * 2 * 128; it += NGW) { const int l = it >> 8, kv = (it >> 7) & 1, j = it & 127;
        const float* w1 = (kv ? p.cv1 : p.ck1) + (size_t)l * 2048 * 128 + j; const float* pe = p.cmp_pe + (size_t)l * 2048; float a = 0.f;
        for (int k = lane; k < 2048; k += 64) a += pe[k] * w1[(size_t)k * 128];
        a = wave_sum(a); if (lane == 0) ((float*)(p.ws + WS_CBIAS))[it] = a; }
}

template <bool RES, bool XBOUT>
__device__ __forceinline__ void row_pass(const float* xi, const float* h, const float* gpost, float* xo, const float* gpre, bf16* xb, int nrows, int wv) {
    const int tid = opaque_tid(wv), lane = tid & 63, wave = wv, gw = opaque_bid() * NWAVES + wave, NGW = gridDim.x * NWAVES;
    for (int m = gw; m < nrows; m += NGW) {
        const f32x4* xr = (const f32x4*)(xi + (size_t)m * DM) + lane;
        f32x4 v[4];
#pragma unroll
        for (int j = 0; j < 4; ++j) v[j] = xr[64 * j];
        if (RES) {
            const f32x4* hr = (const f32x4*)(h + (size_t)m * DM) + lane; f32x4 hv[4]; float s = 0.f;
#pragma unroll
            for (int j = 0; j < 4; ++j) { hv[j] = hr[64 * j]; s += (hv[j].x * hv[j].x + hv[j].y * hv[j].y) + (hv[j].z * hv[j].z + hv[j].w * hv[j].w); }
            const float r1 = rsqrtf(wave_sum(s) * (1.f / DM) + RMS_EPS);
            f32x4* xw = (f32x4*)(xo + (size_t)m * DM) + lane;
#pragma unroll
            for (int j = 0; j < 4; ++j) { const f32x4 g = ((const f32x4*)gpost)[lane + 64 * j]; v[j] = v[j] + hv[j] * r1 * g; xw[64 * j] = v[j]; }
        }
        if (XBOUT) {
            float s2 = 0.f;
#pragma unroll
            for (int j = 0; j < 4; ++j) s2 += (v[j].x * v[j].x + v[j].y * v[j].y) + (v[j].z * v[j].z + v[j].w * v[j].w);
            const float r2 = rsqrtf(wave_sum(s2) * (1.f / DM) + RMS_EPS);
            unsigned long long* o8 = (unsigned long long*)(xb + (size_t)m * DM) + lane;
#pragma unroll
            for (int j = 0; j < 4; ++j) { const f32x4 g = ((const f32x4*)gpre)[lane + 64 * j]; const f32x4 y = v[j] * r2 * g;
                o8[64 * j] = (unsigned long long)pk2(y.x, y.y) | ((unsigned long long)pk2(y.z, y.w) << 32); }
        }
    }
}

__device__ __forceinline__ void conv_part(const Params& p, int ly, int b, int ch, const bf16* proj, bf16* xb, int lane, int wave) {
    {
        const float* cw = p.conv_w + (size_t)ly * 3 * 512 + lane * 8; const float* gn = p.gn_conv + (size_t)ly * 512 + lane * 8;
        for (int tq = wave; tq < 64; tq += NWAVES) {
            const int t = 64 * ch + tq; const size_t row = (size_t)b * SEQ + t;
            float y[8];
#pragma unroll
            for (int e = 0; e < 8; ++e) y[e] = 0.f;
#pragma unroll
            for (int k = 0; k < 3; ++k) if (t - k >= 0) {
                const u32x4 cc = *(const u32x4*)(proj + (row - k) * PROJ_LD + CCC + lane * 8), cx = *(const u32x4*)(proj + (row - k) * PROJ_LD + CCX + lane * 8);
                const float* w = cw + k * 512;
                y[0] += w[0] * bflo(cc.x) * bflo(cx.x); y[1] += w[1] * bfhi(cc.x) * bfhi(cx.x); y[2] += w[2] * bflo(cc.y) * bflo(cx.y); y[3] += w[3] * bfhi(cc.y) * bfhi(cx.y);
                y[4] += w[4] * bflo(cc.z) * bflo(cx.z); y[5] += w[5] * bfhi(cc.z) * bfhi(cx.z); y[6] += w[6] * bflo(cc.w) * bflo(cx.w); y[7] += w[7] * bfhi(cc.w) * bfhi(cx.w); }
            const u32x4 cb = *(const u32x4*)(proj + row * PROJ_LD + CCB + lane * 8);
            y[0] *= bflo(cb.x); y[1] *= bfhi(cb.x); y[2] *= bflo(cb.y); y[3] *= bfhi(cb.y); y[4] *= bflo(cb.z); y[5] *= bfhi(cb.z); y[6] *= bflo(cb.w); y[7] *= bfhi(cb.w);
            float ss = 0.f;
#pragma unroll
            for (int e = 0; e < 8; ++e) ss += y[e] * y[e];
            const float r = rsqrtf(wave_sum(ss) * (1.f / 512.f) + RMS_EPS);
            u32x4 w; w.x = pk2(y[0] * r * gn[0], y[1] * r * gn[1]); w.y = pk2(y[2] * r * gn[2], y[3] * r * gn[3]); w.z = pk2(y[4] * r * gn[4], y[5] * r * gn[5]); w.w = pk2(y[6] * r * gn[6], y[7] * r * gn[7]);
            *(u32x4*)(xb + row * DM + 512 + lane * 8) = w;
        }
    }
}


namespace nsa {
typedef short bf16x8 __attribute__((ext_vector_type(8)));
typedef float f32x16 __attribute__((ext_vector_type(16)));
typedef short s16x4 __attribute__((ext_vector_type(4)));
constexpr int KROWB = 144, KT_BYTES = 64 * KROWB, VT_BYTES = 8192;
constexpr int L_K = 0, L_V = 2 * KT_BYTES, L_TB = L_V + 2 * VT_BYTES, L_TBC = L_TB + 8 * 384 * 4, L_IMPA = L_TBC + 8 * 132 * 4, L_IMPB = L_IMPA + 8192, L_SELM = L_IMPB + 8192, L_END = L_SELM + 256;
constexpr float LOG2E = 1.4426950408889634f, QSCALE = 0.125f * LOG2E, NEG = -2e30f, MINIT = -1e30f;

__device__ __forceinline__ void build_tables(const float* rel_bias, LAS unsigned char* lds, int tid) {
    LAS float* TB = (LAS float*)(lds + L_TB); LAS float* TBC = (LAS float*)(lds + L_TBC);
    for (int e = tid; e < 8 * 384; e += NTHREADS) { const int h = e / 384, x = e % 384, dist = 319 - x; TB[e] = (dist < 0 || dist > 255) ? NEG : rel_bias[h * 32 + T5_BUCKET[dist > 127 ? 127 : dist]] * LOG2E; }
    for (int e = tid; e < 8 * 132; e += NTHREADS) { const int h = e / 132, idx = e % 132; TBC[e] = (idx == 0 || idx > 128) ? NEG : rel_bias[h * 32 + T5_BUCKET[idx - 1]] * LOG2E; }
    __syncthreads();
}
__device__ __forceinline__ float quad_sum(float x) { x += xor1f(x); x += xor2f(x); return x; }
__device__ __forceinline__ unsigned cvtpk(float lo, float hi) { unsigned r; asm volatile("v_cvt_pk_bf16_f32 %0, %1, %2" : "=v"(r) : "v"(lo), "v"(hi)); return r; }
__device__ __forceinline__ s16x4 tr_read(LAS const unsigned char* p) { typedef short v4i16_t __attribute__((ext_vector_type(4))); return __builtin_bit_cast(s16x4, __builtin_amdgcn_ds_read_tr16_b64_v4i16((LAS v4i16_t*)p)); }

struct TileSrc { const bf16* K; const bf16* V; int stride; };
__device__ __forceinline__ void qk_tile(f32x16& p0, f32x16& p1, LAS const unsigned char* kt, const bf16x8 (&qf)[4], int r32, int hi) {
    LAS const unsigned char* kb = kt + r32 * KROWB + hi * 16;
#pragma unroll
    for (int d0 = 0; d0 < 4; ++d0) {
        const bf16x8 a0 = *(LAS const bf16x8*)(kb + d0 * 32), a1 = *(LAS const bf16x8*)(kb + 32 * KROWB + d0 * 32);
        p0 = __builtin_amdgcn_mfma_f32_32x32x16_bf16(a0, qf[d0], p0, 0, 0, 0); p1 = __builtin_amdgcn_mfma_f32_32x32x16_bf16(a1, qf[d0], p1, 0, 0, 0); }
}
__device__ __forceinline__ void pv_tile(f32x16 (&o)[2], LAS const unsigned char* vt, const u32x4 (&pw)[4], int lane) {
    const int hi = lane >> 5, grp = (lane >> 4) & 1, i = lane & 15;
    LAS const unsigned char* vb = vt + (4 * hi + (i >> 2)) * 64 + (16 * grp + 4 * (i & 3)) * 2;
#pragma unroll
    for (int dblk = 0; dblk < 2; ++dblk)
#pragma unroll
        for (int s = 0; s < 4; ++s) {
            const s16x4 lo = tr_read(vb + dblk * 4096 + (16 * s) * 64), hi4 = tr_read(vb + dblk * 4096 + (16 * s + 8) * 64);
            const bf16x8 vf = (bf16x8){lo[0], lo[1], lo[2], lo[3], hi4[0], hi4[1], hi4[2], hi4[3]};
            o[dblk] = __builtin_amdgcn_mfma_f32_32x32x16_bf16(vf, __builtin_bit_cast(bf16x8, pw[s]), o[dblk], 0, 0, 0); }
}
__device__ __forceinline__ float vmax16(const f32x16& a, const f32x16& b) {
    float x = fmaxf(a[0], b[0]);
#pragma unroll
    for (int r = 1; r < 16; ++r) x = fmaxf(x, fmaxf(a[r], b[r]));
    return x;
}
__device__ __forceinline__ void pack_p(u32x4 (&pw)[4], const f32x16& p0, const f32x16& p1) {
    pw[0] = (u32x4){cvtpk(p0[0], p0[1]), cvtpk(p0[2], p0[3]), cvtpk(p0[4], p0[5]), cvtpk(p0[6], p0[7])};
    pw[1] = (u32x4){cvtpk(p0[8], p0[9]), cvtpk(p0[10], p0[11]), cvtpk(p0[12], p0[13]), cvtpk(p0[14], p0[15])};
    pw[2] = (u32x4){cvtpk(p1[0], p1[1]), cvtpk(p1[2], p1[3]), cvtpk(p1[4], p1[5]), cvtpk(p1[6], p1[7])};
    pw[3] = (u32x4){cvtpk(p1[8], p1[9]), cvtpk(p1[10], p1[11]), cvtpk(p1[12], p1[13]), cvtpk(p1[14], p1[15])};
}
template <bool LOOKUP>
__device__ __forceinline__ void soft_tile(f32x16& p0, f32x16& p1, LAS const float* tbp, float& m, float& l, f32x16 (&o)[2], u32x4 (&pw)[4]) {
    if (LOOKUP) {
#pragma unroll
        for (int r = 0; r < 16; ++r) { p0[r] += tbp[(r & 3) + 8 * (r >> 2)]; p1[r] += tbp[32 + (r & 3) + 8 * (r >> 2)]; }
    }
    float mx = vmax16(p0, p1); mx = half_max(mx);
    const float mn = fmaxf(m, mx), alpha = __builtin_amdgcn_exp2f(m - mn); m = mn;
    float rs = 0.f;
#pragma unroll
    for (int r = 0; r < 16; ++r) { p0[r] = __builtin_amdgcn_exp2f(p0[r] - mn); p1[r] = __builtin_amdgcn_exp2f(p1[r] - mn); rs += p0[r] + p1[r]; }
    l = l * alpha + rs;
#pragma unroll
    for (int r = 0; r < 16; ++r) { o[0][r] *= alpha; o[1][r] *= alpha; }
    pack_p(pw, p0, p1);
}

__device__ __forceinline__ void nsa_unit(const Params& p, int b, int c, int g, LAS unsigned char* lds, int wv) {
    const int tid = opaque_tid(wv);
    const int lane = tid & 63, w = wv, r32 = lane & 31, hi = lane >> 5, qi = r32 >> 2, hh = r32 & 3, h = 4 * g + hh, ql = 8 * w + qi, t = 64 * c + ql;
    const size_t row = (size_t)b * SEQ + t;
    const bf16* proj = (const bf16*)(p.ws + WS_PROJ);
    const bf16* kcb = (const bf16*)(p.ws + WS_KCMP) + (size_t)(b * 2 + g) * 128 * 64; const bf16* vcb = (const bf16*)(p.ws + WS_VCMP) + (size_t)(b * 2 + g) * 128 * 64;
    const int skey = tid >> 3, sch = tid & 7;
    LAS unsigned char* kdst = lds + L_K + skey * KROWB + sch * 16; LAS unsigned char* vdst = lds + L_V + (sch >> 2) * 4096 + skey * 64 + (sch & 3) * 16;
    const int NT = 2 + (c + 1) + (c + 1 < 5 ? c + 1 : 5), w0 = c > 4 ? c - 4 : 0;
#define NSA_SRC(i, S_) do { if ((i) < 2) { S_.K = kcb + (size_t)(64 * (i)) * 64; S_.V = vcb + (size_t)(64 * (i)) * 64; S_.stride = 64; } \
        else if ((i) < 3 + c) { S_.K = proj + ((size_t)b * SEQ + 64 * ((i) - 2)) * PROJ_LD + CKS + 64 * g; S_.V = S_.K + (CVS - CKS); S_.stride = PROJ_LD; } \
        else { S_.K = proj + ((size_t)b * SEQ + 64 * (w0 + (i) - 3 - c)) * PROJ_LD + CKW + 64 * g; S_.V = S_.K + (CVW - CKW); S_.stride = PROJ_LD; } } while (0)
#define NSA_LOAD(i) do { TileSrc s_; NSA_SRC(i, s_); kreg = *(const u32x4*)(s_.K + (size_t)skey * s_.stride + sch * 8); vreg = *(const u32x4*)(s_.V + (size_t)skey * s_.stride + sch * 8); } while (0)
#define NSA_WRITE(buf) do { *(LAS u32x4*)(kdst + (buf) * KT_BYTES) = kreg; *(LAS u32x4*)(vdst + (buf) * VT_BYTES) = vreg; } while (0)
    u32x4 kreg, vreg;
    NSA_LOAD(0);
    bf16x8 qf[4];
#pragma unroll
    for (int d0 = 0; d0 < 4; ++d0) qf[d0] = *(const bf16x8*)(proj + row * PROJ_LD + CQ + h * 64 + 16 * d0 + 8 * hi);
    const bf16* gl = proj + row * PROJ_LD + CGL + h * 3;
    const float g0 = 1.f / (1.f + __expf(-__uint_as_float((unsigned)gl[0] << 16))), g1 = 1.f / (1.f + __expf(-__uint_as_float((unsigned)gl[1] << 16))), g2 = 1.f / (1.f + __expf(-__uint_as_float((unsigned)gl[2] << 16)));
    NSA_WRITE(0);
    __syncthreads();
    f32x16 o[2], out[2]; u32x4 pw[4];
    LAS const float* TBh = (LAS const float*)(lds + L_TB) + h * 384; LAS const float* TBCh = (LAS const float*)(lds + L_TBC) + h * 132;
    const float rb31 = TBCh[128];
    unsigned selm;
    {
        f32x16 pa0, pa1, pb0, pb1;
#pragma unroll
        for (int r = 0; r < 16; ++r) { pa0[r] = 0.f; pa1[r] = 0.f; pb0[r] = 0.f; pb1[r] = 0.f; }
        NSA_LOAD(1);
        qk_tile(pa0, pa1, lds + L_K, qf, r32, hi);
        NSA_WRITE(1);
        __syncthreads();
        NSA_LOAD(2);
        qk_tile(pb0, pb1, lds + L_K + KT_BYTES, qf, r32, hi);
        const int Dc = t - 31 - 64 * hi; int hib = 127; asm volatile("" : "+s"(hib));
#pragma unroll
        for (int r = 0; r < 16; ++r) { const int nr = (r & 3) + 8 * (r >> 2);
            { const int d = Dc - 16 * nr; pa0[r] += TBCh[min(max(d, -1), hib) + 1]; }
            { const int d = Dc - 16 * (32 + nr); pa1[r] += TBCh[min(max(d, -1), hib) + 1]; }
            { const int d = Dc - 16 * (64 + nr); pb0[r] += TBCh[min(max(d, -1), hib) + 1]; }
            { const int d = Dc - 16 * (96 + nr); pb1[r] += TBCh[min(max(d, -1), hib) + 1]; } }
        float mx = fmaxf(vmax16(pa0, pa1), vmax16(pb0, pb1)); mx = half_max(mx); mx = fmaxf(mx, MINIT);
        float rs = 0.f;
#pragma unroll
        for (int r = 0; r < 16; ++r) { pa0[r] = __builtin_amdgcn_exp2f(pa0[r] - mx); pa1[r] = __builtin_amdgcn_exp2f(pa1[r] - mx); pb0[r] = __builtin_amdgcn_exp2f(pb0[r] - mx); pb1[r] = __builtin_amdgcn_exp2f(pb1[r] - mx);
            rs += (pa0[r] + pa1[r]) + (pb0[r] + pb1[r]); }
        rs = half_sum(rs);
        const float il = rs > 0.f ? 1.f / rs : 0.f;
#pragma unroll
        for (int r = 0; r < 16; ++r) { pa0[r] *= il; pa1[r] *= il; pb0[r] *= il; pb1[r] *= il; }
        LAS float* IA = (LAS float*)(lds + L_IMPA) + w * 256 + qi * 32; LAS float* IB = (LAS float*)(lds + L_IMPB) + w * 256 + qi * 32;
#pragma unroll
        for (int k = 0; k < 4; ++k) {
            const float a0 = quad_sum((pa0[4 * k] + pa0[4 * k + 1]) + (pa0[4 * k + 2] + 0.5f * pa0[4 * k + 3])), b0 = quad_sum(0.5f * pa0[4 * k + 3]);
            const float a1 = quad_sum((pa1[4 * k] + pa1[4 * k + 1]) + (pa1[4 * k + 2] + 0.5f * pa1[4 * k + 3])), b1 = quad_sum(0.5f * pa1[4 * k + 3]);
            const float a2 = quad_sum((pb0[4 * k] + pb0[4 * k + 1]) + (pb0[4 * k + 2] + 0.5f * pb0[4 * k + 3])), b2 = quad_sum(0.5f * pb0[4 * k + 3]);
            const float a3 = quad_sum((pb1[4 * k] + pb1[4 * k + 1]) + (pb1[4 * k + 2] + 0.5f * pb1[4 * k + 3])), b3 = quad_sum(0.5f * pb1[4 * k + 3]);
            if (hh == 0) { const int j = 2 * k + hi; IA[j] = a0; IB[j] = b0; IA[8 + j] = a1; IB[8 + j] = b1; IA[16 + j] = a2; IB[16 + j] = b2; IA[24 + j] = a3; IB[24 + j] = b3; } }
        asm volatile("s_waitcnt lgkmcnt(0)" ::: "memory");
        if (lane < 8) { unsigned mask;
            if (c < 8) mask = (1u << (c + 1)) - 1u;
            else { mask = 1u | (1u << c) | (1u << (c - 1));
                LAS const float* A = (LAS const float*)(lds + L_IMPA) + w * 256 + lane * 32; LAS const float* B = (LAS const float*)(lds + L_IMPB) + w * 256 + lane * 32;
                for (int rr = 0; rr < 5; ++rr) { int best = 1; float bv = -1.f;
                    for (int j = 1; j <= c - 2; ++j) { const float v = A[j] + B[j - 1]; if (!((mask >> j) & 1u) && v > bv) { bv = v; best = j; } }
                    mask |= 1u << best; } }
            ((LAS unsigned*)(lds + L_SELM))[w * 8 + lane] = mask; }
        asm volatile("s_waitcnt lgkmcnt(0)" ::: "memory");
        selm = ((LAS const unsigned*)(lds + L_SELM))[w * 8 + qi];
#pragma unroll
        for (int r = 0; r < 16; ++r) { o[0][r] = 0.f; o[1][r] = 0.f; }
        pack_p(pw, pa0, pa1); pv_tile(o, lds + L_V, pw, lane);
        pack_p(pw, pb0, pb1); pv_tile(o, lds + L_V + VT_BYTES, pw, lane);
#pragma unroll
        for (int r = 0; r < 16; ++r) { out[0][r] = g0 * o[0][r]; out[1][r] = g0 * o[1][r]; o[0][r] = 0.f; o[1][r] = 0.f; }
        __syncthreads();
        NSA_WRITE(0);
        __syncthreads();
    }
    float m = MINIT, l = 0.f;
    for (int i = 2; i < NT; ++i) {
        const bool more = i + 1 < NT;
        if (more) NSA_LOAD(i + 1);
        const bool win = i >= 3 + c; const int j = win ? w0 + i - 3 - c : i - 2, dj = c - j;
        const bool lookup = dj <= 2 || (win && dj == 4);
        const bool on = win || ((selm >> j) & 1u);
        const float cb = lookup ? (on ? 0.f : NEG) : (on ? rb31 : NEG);
        f32x16 p0, p1;
#pragma unroll
        for (int r = 0; r < 16; ++r) { p0[r] = cb; p1[r] = cb; }
        LAS const unsigned char* kt = lds + L_K + (i & 1) * KT_BYTES; LAS const unsigned char* vt = lds + L_V + (i & 1) * VT_BYTES;
        qk_tile(p0, p1, kt, qf, r32, hi);
        if (lookup) soft_tile<true>(p0, p1, TBh + (319 - (64 * dj + ql) + 4 * hi), m, l, o, pw);
        else soft_tile<false>(p0, p1, TBh, m, l, o, pw);
        pv_tile(o, vt, pw, lane);
        if (i == 2 + c || i == NT - 1) {
            const float lt = half_sum(l), wgt = (win ? g2 : g1) / lt;
#pragma unroll
            for (int r = 0; r < 16; ++r) { out[0][r] += wgt * o[0][r]; out[1][r] += wgt * o[1][r]; o[0][r] = 0.f; o[1][r] = 0.f; }
            m = MINIT; l = 0.f; }
        if (more) NSA_WRITE((i + 1) & 1);
        __syncthreads();
    }
    float* outp = (float*)(p.ws + WS_H) + row * DM + h * 64 + 4 * hi;
#pragma unroll
    for (int dblk = 0; dblk < 2; ++dblk)
#pragma unroll
        for (int k = 0; k < 4; ++k) *(f32x4*)(outp + 32 * dblk + 8 * k) = (f32x4){out[dblk][4 * k], out[dblk][4 * k + 1], out[dblk][4 * k + 2], out[dblk][4 * k + 3]};
#undef NSA_SRC
#undef NSA_LOAD
#undef NSA_WRITE
}
}

__device__ __forceinline__ void nsa_item_mfma(const Params& p, int ly, int item, LAS unsigned char* lds, int wv) {
    const int tid = opaque_tid(wv);
    const int b = item >> 5, ch = item & 31, lane = tid & 63, wave = wv;
    const bf16* proj = (const bf16*)(p.ws + WS_PROJ);
    bf16* xb = (bf16*)(p.ws + WS_XB);
    conv_part(p, ly, b, ch, proj, xb, lane, wave);
    nsa::nsa_unit(p, b, ch, 0, lds, wv);
    nsa::nsa_unit(p, b, ch, 1, lds, wv);
    __syncthreads();
    { const int ql = tid >> 3, h = tid & 7; const size_t row = (size_t)b * SEQ + 64 * ch + ql;
      const f32x4* src = (const f32x4*)((const float*)(p.ws + WS_H) + row * DM + h * 64); f32x4 v[16]; float ss = 0.f;
#pragma unroll
      for (int c = 0; c < 16; ++c) { v[c] = src[c]; ss += (v[c].x * v[c].x + v[c].y * v[c].y) + (v[c].z * v[c].z + v[c].w * v[c].w); }
      ss += xor1f(ss); ss += xor2f(ss); ss += xor4f(ss);
      const float r = rsqrtf(ss * (1.f / 512.f) + RMS_EPS); const f32x4* gn = (const f32x4*)(p.gn_nsa + (size_t)ly * 512 + h * 64);
      u32x4* dst = (u32x4*)(xb + row * DM + h * 64);
#pragma unroll
      for (int c = 0; c < 8; ++c) { const f32x4 a = v[2 * c] * r * gn[2 * c], bb = v[2 * c + 1] * r * gn[2 * c + 1]; u32x4 wv; wv.x = pk2(a.x, a.y); wv.y = pk2(a.z, a.w); wv.z = pk2(bb.x, bb.y); wv.w = pk2(bb.z, bb.w); dst[c] = wv; } }
    __syncthreads();
}

__device__ __forceinline__ void memattn_unit(const Params& p, int ly, int unit, LAS unsigned char* lds, int wv) {
    using namespace nsa;
    const int tid = opaque_tid(wv), lane = tid & 63, w = wv, r32 = lane & 31, hi = lane >> 5;
    const int b = unit >> 5, hm = (unit >> 3) & 3, qb = unit & 7;
    const bf16* kv = (const bf16*)(p.ws + WS_MEMKV) + (size_t)ly * 4096 * 512 + (size_t)b * MEML * 512 + hm * 64;
    constexpr int MK = 0, MV = 4 * KT_BYTES;
    { const int skey = tid >> 3, sch = tid & 7;
      u32x4 kr[4], vr[4];
#pragma unroll
      for (int tt = 0; tt < 4; ++tt) { kr[tt] = *(const u32x4*)(kv + (size_t)(64 * tt + skey) * 512 + sch * 8); vr[tt] = *(const u32x4*)(kv + (size_t)(64 * tt + skey) * 512 + 256 + sch * 8); }
#pragma unroll
      for (int tt = 0; tt < 4; ++tt) { *(LAS u32x4*)(lds + MK + tt * KT_BYTES + skey * KROWB + sch * 16) = kr[tt]; *(LAS u32x4*)(lds + MV + tt * VT_BYTES + (sch >> 2) * 4096 + skey * 64 + (sch & 3) * 16) = vr[tt]; } }
    const size_t row = (size_t)b * SEQ + 256 * qb + 32 * w + r32;
    bf16x8 qf[4];
#pragma unroll
    for (int d0 = 0; d0 < 4; ++d0) qf[d0] = *(const bf16x8*)((const bf16*)(p.ws + WS_QM) + row * 256 + hm * 64 + 16 * d0 + 8 * hi);
    __syncthreads();
    f32x16 o[2]; u32x4 pw[4]; float m = MINIT, l = 0.f;
#pragma unroll
    for (int r = 0; r < 16; ++r) { o[0][r] = 0.f; o[1][r] = 0.f; }
    for (int tt = 0; tt < 4; ++tt) {
        f32x16 p0, p1;
#pragma unroll
        for (int r = 0; r < 16; ++r) { p0[r] = 0.f; p1[r] = 0.f; }
        qk_tile(p0, p1, lds + MK + tt * KT_BYTES, qf, r32, hi);
        soft_tile<false>(p0, p1, (LAS const float*)lds, m, l, o, pw);
        pv_tile(o, lds + MV + tt * VT_BYTES, pw, lane);
    }
    const float il = 1.f / half_sum(l);
    bf16* dst = (bf16*)(p.ws + WS_OM) + row * 256 + hm * 64 + 4 * hi;
#pragma unroll
    for (int dblk = 0; dblk < 2; ++dblk)
#pragma unroll
        for (int k = 0; k < 4; ++k) { const unsigned long long v = (unsigned long long)pk2(o[dblk][4 * k] * il, o[dblk][4 * k + 1] * il) | ((unsigned long long)pk2(o[dblk][4 * k + 2] * il, o[dblk][4 * k + 3] * il) << 32);
            *(unsigned long long*)(dst + 32 * dblk + 8 * k) = v; }
    __syncthreads();
}

#define XB_TMO      128
#define XB_XCNT(j)  (256  + 64 * (j))
#define XB_XSUB(j)  (1280 + 64 * (j))
#define XB_XGEN(j)  (2304 + 64 * (j))
#define XB_TOP      3328
#define XB_TOPGEN   3392
#define XCD_BAR_WORDS 3456
#define XB_SPIN_CAP (1u << 18)

__device__ __forceinline__ unsigned xb_ld(unsigned* p)              { return __hip_atomic_load(p, __ATOMIC_RELAXED, __HIP_MEMORY_SCOPE_AGENT); }
__device__ __forceinline__ unsigned xb_add(unsigned* p, unsigned v) { return __hip_atomic_fetch_add(p, v, __ATOMIC_RELAXED, __HIP_MEMORY_SCOPE_AGENT); }
__device__ __forceinline__ unsigned xb_xcc_id() { return (unsigned)__builtin_amdgcn_s_getreg((3 << 11) | 20) & 0xFu; }
#define XB_SPIN(cond, bar) do { unsigned _sp = 0; while (cond) { __builtin_amdgcn_s_sleep(1); \
    if ((++_sp & 255u) == 0u) { if (xb_ld(&(bar)[XB_TMO])) break; if (_sp > XB_SPIN_CAP) { atomicAdd(&(bar)[XB_TMO], 1u); break; } } } } while (0)

struct XcdBarrier {
    unsigned* bar; unsigned x;
    volatile LAS unsigned* st;
};

__device__ __forceinline__ XcdBarrier xcd_barrier_post(unsigned* bar, volatile LAS unsigned* st, int wv) {
    XcdBarrier b; b.bar = bar; b.x = xb_xcc_id(); b.st = st;
    if (opaque_tid(wv) == 0) (void)xb_add(&bar[XB_XCNT(b.x)], 1u);
    return b;
}
__device__ __forceinline__ void xcd_barrier_complete(unsigned* bar, unsigned x, unsigned& nloc, unsigned& nx) {
    const unsigned G = gridDim.x * gridDim.y * gridDim.z;
    unsigned sum, cnt, mine, sp = 0u;
    for (;;) {
        sum = 0u; cnt = 0u; mine = 0u;
#pragma unroll
        for (unsigned j = 0; j < 16; ++j) { const unsigned c = xb_ld(&bar[XB_XCNT(j)]); sum += c; cnt += (c > 0u) ? 1u : 0u; mine = (j == x) ? c : mine; }
        if (sum == G) break;
        __builtin_amdgcn_s_sleep(1);
        if ((++sp & 255u) == 0u) { if (xb_ld(&bar[XB_TMO])) break; if (sp > XB_SPIN_CAP) { atomicAdd(&bar[XB_TMO], 1u); break; } }
    }
    nloc = mine > 0u ? mine : 1u; nx = cnt > 0u ? cnt : 1u;
}

__device__ __forceinline__ void xcd_barrier(const XcdBarrier& b, int wv) {
    asm volatile("s_waitcnt vmcnt(0)" ::: "memory");
    __syncthreads();
    if (opaque_tid(wv) == 0) {
        unsigned* bar = b.bar; asm volatile("" : "+s"(bar));
        __builtin_amdgcn_s_waitcnt(0);
        unsigned nloc = b.st[0], nx = b.st[1];
        if (nloc == 0u) { xcd_barrier_complete(bar, b.x, nloc, nx); b.st[0] = nloc; b.st[1] = nx; }
        const unsigned old = xb_add(&bar[XB_XSUB(b.x)], 1u);
        const unsigned gen = old / nloc;
        if (old + 1u == (gen + 1u) * nloc) {
            __builtin_amdgcn_fence(__ATOMIC_RELEASE, "agent");
            asm volatile("s_waitcnt vmcnt(0)" ::: "memory");
            const unsigned og = xb_add(&bar[XB_TOP], 1u);
            const unsigned tg = og / nx;
            if (og + 1u == (tg + 1u) * nx) xb_add(&bar[XB_TOPGEN], 1u);
            else XB_SPIN(xb_ld(&bar[XB_TOPGEN]) == tg, bar);
            __builtin_amdgcn_fence(__ATOMIC_ACQUIRE, "agent");
            xb_add(&bar[XB_XGEN(b.x)], 1u);
            asm volatile("s_waitcnt vmcnt(0)" ::: "memory");
        } else {
            XB_SPIN(xb_ld(&bar[XB_XGEN(b.x)]) == gen, bar);
            __builtin_amdgcn_fence(__ATOMIC_ACQUIRE, "agent");
            asm volatile("s_waitcnt vmcnt(0)" ::: "memory");
        }
    }
    __syncthreads();
}

template <class Epi>
__device__ __forceinline__ void run_gemm(LAS unsigned char* lds, int bid, const bf16* A, const bf16* Bt, int M, int N, int K, const Epi& E, int wv, int lda = 0, int blk_shift = 0) {
    pg8::Gemm g{A, Bt, M, N, K, lda ? lda : K}; pg8::StaticOrder S; S.init(M, N, (int)gridDim.x, (int)((unsigned)(bid + blk_shift) % gridDim.x));
    pg8::gemm_phase<Epi, pg8::StaticOrder, !Epi::AFTER_DRAIN, true>(lds, g, S, E, wv);
}

__global__ void __launch_bounds__(NTHREADS, 2) hymba_fwd(Params p) {
    extern __shared__ __attribute__((aligned(16))) unsigned char lds_raw[];
    LAS unsigned char* lds = (LAS unsigned char*)lds_raw;
    cg::grid_group grid = cg::this_grid();
    const int G = gridDim.x;
    const int wv = __builtin_amdgcn_readfirstlane((int)(threadIdx.x >> 6));
    unsigned char* const ws0 = p.ws;
    volatile LAS unsigned* MISC = (volatile LAS unsigned*)(lds + MISC_OFF);
    { const int t0 = opaque_tid(wv); if (t0 < 32) MISC[t0] = 0u; }
    __syncthreads();
    XcdBarrier bar = xcd_barrier_post((unsigned*)(ws0 + WS_CTL) + CW_BAR, MISC + 8, wv);
    int ph = 0, l = 0;
#define PHASE_BEGIN { unsigned char* ws = ws0; asm volatile("" : "+s"(ws)); int bid = blockIdx.x; asm volatile("" : "+s"(bid)); Params q = p; q.ws = ws; \
    bf16* XB = (bf16*)(ws + WS_XB); float* H = (float*)(ws + WS_H); bf16* PROJ = (bf16*)(ws + WS_PROJ); bf16* HID = PROJ; bf16* QM = (bf16*)(ws + WS_QM); bf16* OM = (bf16*)(ws + WS_OM); \
    bf16* MEMN = (bf16*)(ws + WS_MEMN); bf16* MEMKV = (bf16*)(ws + WS_MEMKV); const unsigned char* wl = ws + WS_W + (size_t)l * W_LAYER; const float* nl = p.norms + (size_t)l * 6 * DM; \
    (void)XB; (void)H; (void)PROJ; (void)HID; (void)QM; (void)OM; (void)MEMN; (void)MEMKV; (void)wl; (void)nl;
#define PHASE_END   if (ph == 0) grid.sync(); else if (ph + 1 < N_PHASES) xcd_barrier(bar, wv); } ++ph;

    PHASE_BEGIN
        weights_phase(q, lds, wv);
        row_pass<false, true>(p.x, nullptr, nullptr, nullptr, p.norms, XB, T, wv);
        for (int lm = 0; lm < DEPTH; ++lm) row_pass<false, true>(p.mem, nullptr, nullptr, nullptr, p.mem_norm + lm * DM, MEMN + (size_t)lm * 4096 * DM, BATCH * MEML, wv);
        __syncthreads();
    PHASE_END

    for (l = 0; l < DEPTH; ++l) {
        PHASE_BEGIN
            run_gemm(lds, bid, XB, (const bf16*)(wl + WO_IN), T, PROJ_LD, DM, pg8::EpiStoreBf16{PROJ, PROJ_LD, 2, nsa::QSCALE, (bf16*)(ws + WS_KC2), 2}, wv);
            run_gemm(lds, bid, MEMN + (size_t)l * 4096 * DM, (const bf16*)(wl + WO_KV), BATCH * MEML, 512, DM, pg8::EpiStoreBf16{MEMKV + (size_t)l * 4096 * 512, 512, 0, 1.f, nullptr, -1}, wv);
        PHASE_END
        PHASE_BEGIN
            { const float* cbl = (const float*)(ws + WS_CBIAS) + l * 256;
              run_gemm(lds, bid, (const bf16*)(ws + WS_KC2), (const bf16*)(wl + WO_C1), 4096, 256, 2048, pg8::EpiCompress<0>{cbl, p.ck2 + (size_t)l * 128 * 64, (bf16*)(ws + WS_KCMP)}, wv, 1024, 0);
              run_gemm(lds, bid, (const bf16*)(ws + WS_KC2) + (size_t)4096 * 1024, (const bf16*)(wl + WO_C1), 4096, 256, 2048, pg8::EpiCompress<1>{cbl + 128, p.cv2 + (size_t)l * 128 * 64, (bf16*)(ws + WS_VCMP)}, wv, 1024, 128); }
        PHASE_END
        PHASE_BEGIN
            nsa::build_tables(p.rel_bias, lds, opaque_tid(wv));
            for (int it = bid; it < BATCH * 32; it += G) nsa_item_mfma(q, l, (it & ~31) | (it < 256 ? 31 - (it & 31) : (it & 31)), lds, wv);
        PHASE_END
        PHASE_BEGIN
            run_gemm(lds, bid, XB, (const bf16*)(wl + WO_OUT), T, DM, DM, pg8::EpiStoreF32{H, DM}, wv);
        PHASE_END
        PHASE_BEGIN
            row_pass<true, true>(l == 0 ? p.x : p.out, H, nl + DM, p.out, nl + 2 * DM, XB, T, wv);
        PHASE_END
        PHASE_BEGIN
            run_gemm(lds, bid, XB, (const bf16*)(wl + WO_Q), T, 256, DM, pg8::EpiStoreBf16{QM, 256, 1, nsa::QSCALE, nullptr, -1}, wv);
        PHASE_END
        PHASE_BEGIN
            for (int it = bid; it < BATCH * 32; it += G) memattn_unit(q, l, it, lds, wv);
        PHASE_END
        PHASE_BEGIN
            run_gemm(lds, bid, OM, (const bf16*)(wl + WO_O), T, DM, 256, pg8::EpiStoreF32{H, DM}, wv);
        PHASE_END
        PHASE_BEGIN
            row_pass<true, true>(p.out, H, nl + 3 * DM, p.out, nl + 4 * DM, XB, T, wv);
        PHASE_END
        PHASE_BEGIN
            run_gemm(lds, bid, XB, (const bf16*)(wl + WO_GU), T, 2 * FFN, DM, pg8::EpiSwiGLU{HID, FFN}, wv);
        PHASE_END
        PHASE_BEGIN
            run_gemm(lds, bid, HID, (const bf16*)(wl + WO_D), T, DM, FFN, pg8::EpiStoreF32{H, DM}, wv);
        PHASE_END
        PHASE_BEGIN
            if (l + 1 < DEPTH) row_pass<true, true>(p.out, H, nl + 5 * DM, p.out, nl + 6 * DM, XB, T, wv);
            else row_pass<true, false>(p.out, H, nl + 5 * DM, p.out, nullptr, nullptr, T, wv);
        PHASE_END
    }
}

extern "C" void kernel_launch(void* const* d_in, const int* in_sizes, int n_in, void* d_out, int out_size, void* d_ws, size_t ws_size, hipStream_t stream) {
    static int grid = 0;
    if (grid == 0) {
        if (n_in != 21 || in_sizes[0] != T * DM || out_size != T * DM || ws_size < WS_END) { fprintf(stderr, "kernel_launch: unexpected problem (n_in %d, in0 %d, out %d, ws %zu < %zu)\n", n_in, n_in > 0 ? in_sizes[0] : -1, out_size, ws_size, (size_t)WS_END); grid = -1; return; }
        int dev = 0, cus = 0, per_cu = 0;
        if (hipGetDevice(&dev) != hipSuccess || hipDeviceGetAttribute(&cus, hipDeviceAttributeMultiprocessorCount, dev) != hipSuccess) { grid = -1; return; }
        if (hipFuncSetAttribute((const void*)hymba_fwd, hipFuncAttributeMaxDynamicSharedMemorySize, LDS_BYTES) != hipSuccess) { fprintf(stderr, "kernel_launch: hipFuncSetAttribute failed\n"); grid = -1; return; }
        if (hipOccupancyMaxActiveBlocksPerMultiprocessor(&per_cu, (const void*)hymba_fwd, NTHREADS, LDS_BYTES) != hipSuccess || per_cu < 1) { fprintf(stderr, "kernel_launch: occupancy query says %d blocks per CU\n", per_cu); grid = -1; return; }
        grid = cus;
    }
    if (grid < 0) return;
    Params p{};
    const float** fp = (const float**)&p;
    for (int i = 0; i < 21; ++i) fp[i] = (const float*)d_in[i];
    p.out = (float*)d_out; p.ws = (unsigned char*)d_ws;
    if (hipMemsetAsync((char*)d_ws + WS_CTL, 0, CTL_ZERO_BYTES, stream) != hipSuccess) { fprintf(stderr, "kernel_launch: hipMemsetAsync failed\n"); return; }
    { void* args[] = {&p};
      hipError_t e = hipLaunchCooperativeKernel((void*)hymba_fwd, dim3(grid), dim3(NTHREADS), args, LDS_BYTES, stream);
      if (e != hipSuccess) fprintf(stderr, "cooperative launch failed: %s (grid %d)\n", hipGetErrorString(e), grid); }
}
```

```cpp
#include <hip/hip_runtime.h>
#include <hip/hip_cooperative_groups.h>
#include <cstdio>
#include <cstdint>
namespace cg = cooperative_groups;
namespace pg8 {
#define PG8_LAS __attribute__((address_space(3)))
typedef unsigned short bf16_t;
typedef short bf16x8 __attribute__((ext_vector_type(8)));
typedef float f32x4 __attribute__((ext_vector_type(4)));
typedef unsigned u32x4 __attribute__((ext_vector_type(4)));
constexpr int BM = 256, BK = 64, HALF = 128, HTB = HALF * BK * 2  , STAGE_BYTES = 8 * HTB, NXCD = 8, WGM = 8;

__host__ __device__ __forceinline__ int lds_byte(int r, int c) { const int st = (r >> 4) * 2 + (c >> 5), rr = r & 15, cc = c & 31, ob = rr * 64 + cc * 2; return st * 1024 + (ob ^ (((ob >> 9) & 1) << 5)); }
__host__ __device__ __forceinline__ void stage_rc(int b, int& R, int& C) { const int st = b / 1024, sb = b % 1024, swz = sb ^ (((sb >> 9) & 1) << 5); R = (st >> 1) * 16 + swz / 64; C = (st & 1) * 32 + (swz % 64) / 2; }
__host__ __device__ __forceinline__ int perm32(int rho) { const int n = rho >> 4, i = rho & 15; return 8 * (i >> 2) + 4 * n + (i & 3); }

struct Unit { int pm, pn; };
struct Gemm { const bf16_t* A; const bf16_t* Bt; int M, N, K, lda; };

struct StaticOrder {
    int nM, nN, nwg, G, c;
    __host__ __device__ void init(int M, int N, int G_, int c_) { nM = M / BM; nN = N / BM; nwg = nM * nN; G = G_; c = c_; }
    __host__ __device__ bool next(int i, Unit& u) const {
        const long L = (long)i * G + c; if (L >= nwg) return false;
        int wgid = (int)L; { const int q = nwg / NXCD, r = nwg % NXCD, xcd = wgid % NXCD, off = wgid / NXCD; wgid = (xcd < r ? xcd * (q + 1) : r * (q + 1) + (xcd - r) * q) + off; }
        const int nig = WGM * nN, gid = wgid / nig, fm = gid * WGM, gsz = (nM - fm) < WGM ? (nM - fm) : WGM;
        u.pm = fm + ((wgid % nig) % gsz); u.pn = (wgid % nig) / gsz; return true;
    }
    __device__ __forceinline__ void a_ready(const Unit&) const {}
    __device__ __forceinline__ void done(const Unit&) const {}
};

__device__ __forceinline__ unsigned cvt_pk_bf16(float lo, float hi) { unsigned r; asm volatile("v_cvt_pk_bf16_f32 %0, %1, %2" : "=v"(r) : "v"(lo), "v"(hi)); return r; }
typedef float f32x2 __attribute__((ext_vector_type(2)));
struct EpiStoreBf16 {
    static constexpr bool PERM = true, AFTER_DRAIN = false;
    bf16_t* O; int ldc; int scale_tiles; float scale;
    bf16_t* R; int rtile;
    __device__ __forceinline__ void operator()(const f32x4 (&acc)[2][2][4][2], const Unit& u, int wr, int wc, int fr, int fq) const {
        const int row0 = u.pm * BM + wr * 64 + fr, col0 = u.pn * BM + wc * 32 + 8 * fq; const float sc = u.pn < scale_tiles ? scale : 1.f;
#pragma unroll
        for (int ai = 0; ai < 2; ++ai)
#pragma unroll
            for (int m = 0; m < 4; ++m) { const int row = row0 + ai * HALF + m * 16; bf16_t* rowp = O + (size_t)row * ldc + col0;
#pragma unroll
                for (int bj = 0; bj < 2; ++bj) { const f32x4 v0 = acc[ai][bj][m][0] * sc, v1 = acc[ai][bj][m][1] * sc;
                    u32x4 w; w.x = cvt_pk_bf16(v0[0], v0[1]); w.y = cvt_pk_bf16(v0[2], v0[3]); w.z = cvt_pk_bf16(v1[0], v1[1]); w.w = cvt_pk_bf16(v1[2], v1[3]);
                    if (u.pn == rtile) { const int c64 = wc * 32 + 8 * fq; *(u32x4*)(R + ((size_t)((bj * 16 + (row >> 11)) * 2 + (c64 >> 6)) * 2048 + (row & 2047)) * 64 + (c64 & 63)) = w; }
                    else *(u32x4*)(rowp + bj * HALF) = w; } }
    }
};
struct EpiStoreF32 {
    static constexpr bool PERM = true, AFTER_DRAIN = false;
    float* O; int ldc;
    __device__ __forceinline__ void operator()(const f32x4 (&acc)[2][2][4][2], const Unit& u, int wr, int wc, int fr, int fq) const {
        const int row0 = u.pm * BM + wr * 64 + fr, col0 = u.pn * BM + wc * 32 + 8 * fq;
#pragma unroll
        for (int ai = 0; ai < 2; ++ai)
#pragma unroll
            for (int m = 0; m < 4; ++m) { float* rowp = O + (size_t)(row0 + ai * HALF + m * 16) * ldc + col0;
#pragma unroll
                for (int bj = 0; bj < 2; ++bj) { *(f32x4*)(rowp + bj * HALF) = acc[ai][bj][m][0]; *(f32x4*)(rowp + bj * HALF + 4) = acc[ai][bj][m][1]; } }
    }
};
struct EpiSwiGLU {
    static constexpr bool PERM = true, AFTER_DRAIN = false;
    bf16_t* O; int ldc;
    __device__ __forceinline__ void operator()(const f32x4 (&acc)[2][2][4][2], const Unit& u, int wr, int wc, int fr, int fq) const {
        const int row0 = u.pm * BM + wr * 64 + fr, col0 = u.pn * HALF + wc * 32 + 8 * fq;
#pragma unroll
        for (int ai = 0; ai < 2; ++ai)
#pragma unroll
            for (int m = 0; m < 4; ++m) { bf16_t* rowp = O + (size_t)(row0 + ai * HALF + m * 16) * ldc + col0;
                float h[8];
#pragma unroll
                for (int n = 0; n < 2; ++n)
#pragma unroll
                    for (int i = 0; i < 4; ++i) { const float g = acc[ai][0][m][n][i], up = acc[ai][1][m][n][i]; h[4 * n + i] = g * up / (1.0f + __expf(-g)); }
                u32x4 w; w.x = cvt_pk_bf16(h[0], h[1]); w.y = cvt_pk_bf16(h[2], h[3]); w.z = cvt_pk_bf16(h[4], h[5]); w.w = cvt_pk_bf16(h[6], h[7]);
                *(u32x4*)rowp = w; }
    }
};

template <int SEL> struct EpiCompress {
    static constexpr bool PERM = true, AFTER_DRAIN = true;
    const float* cbias; const float* w2; bf16_t* dst;
    __device__ __forceinline__ void fused(f32x4 (&acc)[2][2][4][2], const Unit& u, int wr, int wc, int fr, int fq, PG8_LAS unsigned char* lds, int wid, int lane) const {
        constexpr int HROW = 272;
        PG8_LAS float* W2 = (PG8_LAS float*)lds; PG8_LAS unsigned char* HID = lds + 32768;
        const int tid = wid * 64 + lane;
        for (int i = tid; i < 128 * 64 / 4; i += 512) ((PG8_LAS f32x4*)W2)[i] = ((const f32x4*)w2)[i];
        const int colb = wc * 32 + 8 * fq; const f32x4 cb0 = *(const f32x4*)(cbias + colb), cb1 = *(const f32x4*)(cbias + colb + 4);
#pragma unroll
        for (int ai = 0; ai < 2; ++ai)
#pragma unroll
            for (int m = 0; m < 4; ++m) { const int row = ai * HALF + wr * 64 + m * 16 + fr; f32x4 v0 = acc[ai][SEL][m][0] + cb0, v1 = acc[ai][SEL][m][1] + cb1; float hv[8];
#pragma unroll
                for (int i = 0; i < 4; ++i) { const float x0 = v0[i], x1 = v1[i];
                    hv[i] = x0 / (1.0f + __expf(-1.5957691216057308f * (x0 + 0.044715f * x0 * x0 * x0))); hv[4 + i] = x1 / (1.0f + __expf(-1.5957691216057308f * (x1 + 0.044715f * x1 * x1 * x1))); }
                u32x4 w; w.x = cvt_pk_bf16(hv[0], hv[1]); w.y = cvt_pk_bf16(hv[2], hv[3]); w.z = cvt_pk_bf16(hv[4], hv[5]); w.w = cvt_pk_bf16(hv[6], hv[7]);
                *(PG8_LAS u32x4*)(HID + row * HROW + colb * 2) = w; }
        asm volatile("s_waitcnt lgkmcnt(0)" ::: "memory"); __builtin_amdgcn_s_barrier(); asm volatile("" ::: "memory");
        const int row = tid >> 1, eh = tid & 1; float a[32];
#pragma unroll
        for (int i = 0; i < 32; ++i) a[i] = 0.f;
#pragma unroll 2
        for (int j = 0; j < 128; ++j) { const float hvv = __uint_as_float((unsigned)*(const PG8_LAS unsigned short*)(HID + row * HROW + j * 2) << 16);
            const PG8_LAS f32x4* wrow = (const PG8_LAS f32x4*)(W2 + j * 64 + 32 * eh);
#pragma unroll
            for (int e4 = 0; e4 < 8; ++e4) { const f32x4 wv = wrow[e4]; a[4 * e4] += hvv * wv[0]; a[4 * e4 + 1] += hvv * wv[1]; a[4 * e4 + 2] += hvv * wv[2]; a[4 * e4 + 3] += hvv * wv[3]; } }
        bf16_t* o = dst + (size_t)(u.pm * BM + row) * 64 + 32 * eh;
#pragma unroll
        for (int c = 0; c < 4; ++c) { u32x4 w; w.x = cvt_pk_bf16(a[8 * c], a[8 * c + 1]); w.y = cvt_pk_bf16(a[8 * c + 2], a[8 * c + 3]); w.z = cvt_pk_bf16(a[8 * c + 4], a[8 * c + 5]); w.w = cvt_pk_bf16(a[8 * c + 6], a[8 * c + 7]); *(u32x4*)(o + 8 * c) = w; }
        asm volatile("s_waitcnt lgkmcnt(0)" ::: "memory"); __builtin_amdgcn_s_barrier(); asm volatile("" ::: "memory");
    }
};
template <class Epi, class Sched, bool ALIGN_EPI = false, bool SP2 = false>
__device__ __forceinline__ void gemm_phase(PG8_LAS unsigned char* lds, const Gemm g, const Sched& S, const Epi& E, const int wv) {
    int tid_raw; { unsigned ones = ~0u; asm volatile("" : "+s"(ones)); tid_raw = __builtin_amdgcn_mbcnt_hi(ones, __builtin_amdgcn_mbcnt_lo(ones, 0u)) + 64 * wv; }
    const int tid = tid_raw, wid = wv, lane = tid & 63, wr = wid >> 2, wc = wid & 3, fr = lane & 15, fq = lane >> 4;
    const int K = g.K, nt = K / BK;
    unsigned voffA[2], voffB[2];
#pragma unroll
    for (int i = 0; i < 2; ++i) { int R, C; stage_rc(tid * 16 + i * 8192, R, C); const int Rb = Epi::PERM ? ((R & ~31) + perm32(R & 31)) : R;
        voffA[i] = (unsigned)(R * g.lda + C) * 2u; voffB[i] = (unsigned)(Rb * K + C) * 2u; }
    const size_t kstep = (size_t)(BK * 2);
    const size_t hstep = (size_t)HALF * K * 2;
    const size_t tstep = 2 * hstep;
    const size_t hstepA = (size_t)HALF * g.lda * 2, tstepA = 2 * hstepA;
    const unsigned ldsw = (unsigned)wid * 1024u;
    const int aoff = lds_byte(wr * 64 + fr, fq * 8), boff = lds_byte(wc * 32 + fr, fq * 8);
#define PG8_SA(b, h) (((b) * 2 + (h)) * HTB)
#define PG8_SB(b, h) ((4 + (b) * 2 + (h)) * HTB)
#define PG8_STAGE(bufoff, gbase, voff) do { _Pragma("unroll") for (int _i = 0; _i < 2; ++_i) \
        __builtin_amdgcn_global_load_lds((const unsigned*)((const char*)(gbase) + (voff)[_i]), (PG8_LAS unsigned*)(lds + (bufoff) + ldsw + _i * 8192), 16, 0, 0); } while (0)
#define PG8_LDA(dst, b, h) do { _Pragma("unroll") for (int m = 0; m < 4; ++m) _Pragma("unroll") for (int k = 0; k < 2; ++k) dst[m][k] = *(const PG8_LAS bf16x8*)(lds + PG8_SA(b, h) + aoff + m * 2048 + k * 1024); } while (0)
#define PG8_LDB(dst, b, h) do { _Pragma("unroll") for (int n = 0; n < 2; ++n) _Pragma("unroll") for (int k = 0; k < 2; ++k) dst[n][k] = *(const PG8_LAS bf16x8*)(lds + PG8_SB(b, h) + boff + n * 2048 + k * 1024); } while (0)
#define PG8_MMA(ai, bj, At, Bt) do { __builtin_amdgcn_s_setprio(1); _Pragma("unroll") for (int m = 0; m < 4; ++m) _Pragma("unroll") for (int n = 0; n < 2; ++n) _Pragma("unroll") for (int k = 0; k < 2; ++k) \
        acc[ai][bj][m][n] = __builtin_amdgcn_mfma_f32_16x16x32_bf16(Bt[n][k], At[m][k], acc[ai][bj][m][n], 0, 0, 0); __builtin_amdgcn_s_setprio(0); } while (0)
#define PG8_WAIT_V(n) asm volatile("s_waitcnt vmcnt(" #n ")" ::: "memory")
#define PG8_WAIT_L(n) asm volatile("s_waitcnt lgkmcnt(" #n ")" ::: "memory")
#define PG8_BAR __builtin_amdgcn_s_barrier()
#define PG8_SCHED __builtin_amdgcn_sched_barrier(0)
    Unit cur, nxt; int ui = 0;
    if (!S.next(0, cur)) return;
    f32x4 acc[2][2][4][2];
#pragma unroll
    for (int a = 0; a < 2; ++a)
#pragma unroll
        for (int b = 0; b < 2; ++b)
#pragma unroll
            for (int m = 0; m < 4; ++m)
#pragma unroll
                for (int n = 0; n < 2; ++n) acc[a][b][m][n] = (f32x4){0.f, 0.f, 0.f, 0.f};
    bf16x8 At[4][2], B0[2][2], B1[2][2];
    const char* cA = (const char*)g.A + (size_t)cur.pm * tstepA; const char* cB = (const char*)g.Bt + (size_t)cur.pn * tstep;
    S.a_ready(cur);
    if constexpr (SP2) {
        PG8_STAGE(PG8_SB(0, 0), cB, voffB); PG8_STAGE(PG8_SB(0, 1), cB + hstep, voffB); PG8_STAGE(PG8_SA(0, 0), cA, voffA); PG8_STAGE(PG8_SA(0, 1), cA + hstepA, voffA);
        if (wr == 1) PG8_BAR;
        PG8_WAIT_V(2); PG8_BAR;
        PG8_STAGE(PG8_SB(1, 0), cB + kstep, voffB); PG8_STAGE(PG8_SA(1, 0), cA + kstep, voffA); PG8_STAGE(PG8_SB(1, 1), cB + hstep + kstep, voffB);
        PG8_WAIT_V(6); PG8_BAR;
    } else {
        PG8_STAGE(PG8_SB(0, 0), cB, voffB); PG8_STAGE(PG8_SA(0, 0), cA, voffA); PG8_STAGE(PG8_SB(0, 1), cB + hstep, voffB); PG8_STAGE(PG8_SA(0, 1), cA + hstepA, voffA);
        if (wr == 1) PG8_BAR;
        PG8_WAIT_V(4); PG8_BAR;
        PG8_STAGE(PG8_SB(1, 0), cB + kstep, voffB); PG8_STAGE(PG8_SA(1, 0), cA + kstep, voffA); PG8_STAGE(PG8_SB(1, 1), cB + hstep + kstep, voffB);
        PG8_WAIT_V(6); PG8_BAR;
    }
    for (;;) {
        const bool has_next = S.next(ui + 1, nxt);
        const char* nA = has_next ? (const char*)g.A + (size_t)nxt.pm * tstepA : cA; const char* nB = has_next ? (const char*)g.Bt + (size_t)nxt.pn * tstep : cB;
        for (int t = 0; t < nt; t += 2) {
            const bool last = (t == nt - 2);
            const char* a1 = cA + (size_t)(t + 1) * kstep;
            const char* a2 = last ? nA : cA + (size_t)(t + 2) * kstep; const char* b2 = last ? nB : cB + (size_t)(t + 2) * kstep;
            const char* a3 = a2 + kstep; const char* b3 = b2 + kstep;
            if (last && has_next) S.a_ready(nxt);
            if constexpr (SP2) {
            PG8_LDB(B0, 0, 0); PG8_LDB(B1, 0, 1); PG8_SCHED; PG8_LDA(At, 0, 0); PG8_STAGE(PG8_SA(1, 1), a1 + hstepA, voffA);
            PG8_WAIT_V(8); PG8_WAIT_L(0); PG8_BAR; PG8_MMA(0, 0, At, B0); PG8_MMA(0, 1, At, B1); PG8_BAR; PG8_SCHED;
            PG8_LDA(At, 0, 1); PG8_STAGE(PG8_SB(0, 0), b2, voffB); PG8_STAGE(PG8_SB(0, 1), b2 + hstep, voffB); PG8_STAGE(PG8_SA(0, 0), a2, voffA);
            PG8_WAIT_V(8); PG8_WAIT_L(0); PG8_BAR; PG8_MMA(1, 0, At, B0); PG8_MMA(1, 1, At, B1); PG8_BAR; PG8_SCHED;
            PG8_LDB(B0, 1, 0); PG8_LDB(B1, 1, 1); PG8_SCHED; PG8_LDA(At, 1, 0); PG8_STAGE(PG8_SA(0, 1), a2 + hstepA, voffA);
            PG8_WAIT_V(8); PG8_WAIT_L(0); PG8_BAR; PG8_MMA(0, 0, At, B0); PG8_MMA(0, 1, At, B1); PG8_BAR; PG8_SCHED;
            PG8_LDA(At, 1, 1); PG8_STAGE(PG8_SB(1, 0), b3, voffB); PG8_STAGE(PG8_SB(1, 1), b3 + hstep, voffB); PG8_STAGE(PG8_SA(1, 0), a3, voffA);
            PG8_WAIT_V(8); PG8_WAIT_L(0); PG8_BAR; PG8_MMA(1, 0, At, B0); PG8_MMA(1, 1, At, B1); PG8_BAR; PG8_SCHED;
            } else {
            PG8_LDB(B0, 0, 0); PG8_SCHED; PG8_LDA(At, 0, 0); PG8_STAGE(PG8_SA(1, 1), a1 + hstepA, voffA);
            PG8_WAIT_L(8); PG8_BAR; PG8_WAIT_L(0); PG8_MMA(0, 0, At, B0); PG8_BAR; PG8_SCHED;
            PG8_LDB(B1, 0, 1); PG8_STAGE(PG8_SB(0, 0), b2, voffB);
            PG8_BAR; PG8_WAIT_L(0); PG8_MMA(0, 1, At, B1); PG8_BAR;
            PG8_LDA(At, 0, 1); PG8_STAGE(PG8_SA(0, 0), a2, voffA);
            PG8_BAR; PG8_WAIT_L(0); PG8_MMA(1, 0, At, B0); PG8_BAR; PG8_SCHED;
            PG8_STAGE(PG8_SB(0, 1), b2 + hstep, voffB);
            PG8_WAIT_V(6); PG8_BAR; PG8_MMA(1, 1, At, B1); PG8_BAR;
            PG8_LDB(B0, 1, 0); PG8_SCHED; PG8_LDA(At, 1, 0); PG8_STAGE(PG8_SA(0, 1), a2 + hstepA, voffA);
            PG8_WAIT_L(8); PG8_BAR; PG8_WAIT_L(0); PG8_MMA(0, 0, At, B0); PG8_BAR; PG8_SCHED;
            PG8_LDB(B1, 1, 1); PG8_STAGE(PG8_SB(1, 0), b3, voffB);
            PG8_BAR; PG8_WAIT_L(0); PG8_MMA(0, 1, At, B1); PG8_BAR;
            PG8_LDA(At, 1, 1); PG8_STAGE(PG8_SA(1, 0), a3, voffA);
            PG8_BAR; PG8_WAIT_L(0); PG8_MMA(1, 0, At, B0); PG8_BAR; PG8_SCHED;
            PG8_STAGE(PG8_SB(1, 1), b3 + hstep, voffB);
            PG8_WAIT_V(6); PG8_BAR; PG8_MMA(1, 1, At, B1); PG8_BAR;
            }
        }
        if constexpr (ALIGN_EPI) { if (wr == 0) PG8_BAR; }
        if constexpr (!Epi::AFTER_DRAIN) { E(acc, cur, wr, wc, fr, fq); S.done(cur); }
        if (!has_next) break;
#pragma unroll
        for (int a = 0; a < 2; ++a)
#pragma unroll
            for (int b = 0; b < 2; ++b)
#pragma unroll
                for (int m = 0; m < 4; ++m)
#pragma unroll
                    for (int n = 0; n < 2; ++n) acc[a][b][m][n] = (f32x4){0.f, 0.f, 0.f, 0.f};
        cur = nxt; cA = nA; cB = nB; ++ui;
        if constexpr (ALIGN_EPI) { if (wr == 1) PG8_BAR; }
    }
    PG8_WAIT_V(0);
    if constexpr (!ALIGN_EPI) { if (wr == 0) PG8_BAR; }
    PG8_BAR;
    if constexpr (Epi::AFTER_DRAIN) { E.fused(acc, cur, wr, wc, fr, fq, lds, wid, lane); S.done(cur); }
#undef PG8_SA
#undef PG8_SB
#undef PG8_STAGE
#undef PG8_LDA
#undef PG8_LDB
#undef PG8_MMA
#undef PG8_WAIT_V
#undef PG8_WAIT_L
#undef PG8_BAR
#undef PG8_SCHED
}
}
#define LAS __attribute__((address_space(3)))
typedef unsigned short bf16;
typedef unsigned u32x4 __attribute__((ext_vector_type(4)));
typedef float f32x4 __attribute__((ext_vector_type(4)));
constexpr int BATCH = 16, SEQ = 2048, DM = 1024, T = BATCH * SEQ, DEPTH = 2;
constexpr int IN_W = 2840, PROJ_LD = 3072, FFN = 2816, MEML = 256;
constexpr int CQ = 0, CKC = 512, CVC = 640, CKS = 768, CVS = 896, CKW = 1024, CVW = 1152, CCB = 1280, CCC = 1792, CCX = 2304, CGL = 2816;
constexpr float RMS_EPS = 1e-6f;
constexpr int NWAVES = 8, NTHREADS = 512;
constexpr int LDS_BYTES = 147456, MISC_OFF = 131072 + 320;
constexpr int N_PHASES = 1 + 2 * 12;
constexpr size_t WS_CTL = 0; constexpr int CW_BAR = 4096, CTL_ZERO_BYTES = 65536;
constexpr size_t MiB = 1u << 20;
constexpr size_t WS_W = 1 * MiB, W_LAYER = 28 * MiB;
constexpr size_t WO_IN = 0, WO_OUT = 6 * MiB, WO_Q = 8 * MiB, WO_KV = 8 * MiB + 512 * 1024, WO_O = 9 * MiB + 512 * 1024, WO_GU = 10 * MiB, WO_D = 21 * MiB, WO_C1 = 27 * MiB;
constexpr size_t WS_MEMN = 57 * MiB, WS_MEMKV = 73 * MiB, WS_KCMP = 81 * MiB, WS_VCMP = 82 * MiB, WS_CBIAS = 83 * MiB, WS_QM = 84 * MiB, WS_OM = 100 * MiB, WS_XB = 116 * MiB, WS_H = 180 * MiB, WS_PROJ = 308 * MiB, WS_END = 500 * MiB;
constexpr size_t WS_KC2 = WS_QM;

__device__ const int T5_BUCKET[128] = {0,1,2,3,4,5,6,7,8,9,10,11,12,13,14,15,16,16,16,17,17,18,18,18,19,19,19,20,20,20,20,21,21,21,21,22,22,22,22,22,23,23,23,23,23,23,24,24,24,24,24,24,25,25,25,25,25,25,25,26,26,26,26,26,26,26,26,27,27,27,27,27,27,27,27,27,27,28,28,28,28,28,28,28,28,28,28,29,29,29,29,29,29,29,29,29,29,29,29,30,30,30,30,30,30,30,30,30,30,30,30,30,30,31,31,31,31,31,31,31,31,31,31,31,31,31,31,31};

struct Params {
    const float *x, *mem, *rel_bias, *norms, *mem_norm, *gn_nsa, *gn_conv, *w_in, *w_out, *cmp_pe, *ck1, *ck2, *cv1, *cv2, *conv_w, *mem_wq, *mem_wkv, *mem_wo, *ffn_wg, *ffn_wu, *ffn_wd;
    float* out; unsigned char* ws;
};

__device__ __forceinline__ unsigned f2bf(float f) { unsigned u = __builtin_bit_cast(unsigned, f); return (u + 0x7fffu + ((u >> 16) & 1u)) >> 16; }
__device__ __forceinline__ unsigned pk2(float lo, float hi) { return f2bf(lo) | (f2bf(hi) << 16); }
__device__ __forceinline__ float bflo(unsigned u) { return __uint_as_float(u << 16); }
__device__ __forceinline__ float bfhi(unsigned u) { return __uint_as_float(u & 0xffff0000u); }
template <int CTRL> __device__ __forceinline__ float dppf(float x) { return __builtin_bit_cast(float, __builtin_amdgcn_update_dpp(0, __builtin_bit_cast(int, x), CTRL, 0xf, 0xf, true)); }
template <int PAT> __device__ __forceinline__ float swzf(float x) { return __builtin_bit_cast(float, __builtin_amdgcn_ds_swizzle(__builtin_bit_cast(int, x), PAT)); }
__device__ __forceinline__ float xor1f(float x) { return dppf<0xB1>(x); }
__device__ __forceinline__ float xor2f(float x) { return dppf<0x4E>(x); }
__device__ __forceinline__ float xor4f(float x) { return swzf<0x101F>(x); }
__device__ __forceinline__ float xor8f(float x) { return swzf<0x201F>(x); }
__device__ __forceinline__ float xor16f(float x) { return swzf<0x401F>(x); }
__device__ __forceinline__ float half_sum(float x) { auto rr = __builtin_amdgcn_permlane32_swap(__float_as_uint(x), __float_as_uint(x), false, false); return __uint_as_float(rr[0]) + __uint_as_float(rr[1]); }
__device__ __forceinline__ float half_max(float x) { auto rr = __builtin_amdgcn_permlane32_swap(__float_as_uint(x), __float_as_uint(x), false, false); return fmaxf(__uint_as_float(rr[0]), __uint_as_float(rr[1])); }
__device__ __forceinline__ float wave_sum(float v) { v += xor1f(v); v += xor2f(v); v += xor4f(v); v += xor8f(v); v += xor16f(v); return half_sum(v); }
#define LDS_WAIT() asm volatile("s_waitcnt lgkmcnt(0)" ::: "memory")
__device__ __forceinline__ int opaque_lane() { unsigned ones = ~0u; asm volatile("" : "+s"(ones)); return __builtin_amdgcn_mbcnt_hi(ones, __builtin_amdgcn_mbcnt_lo(ones, 0u)); }
__device__ __forceinline__ int opaque_bid() { int b = blockIdx.x; asm volatile("" : "+s"(b)); return b; }
__device__ __forceinline__ int opaque_tid(int wv) { return opaque_lane() + 64 * wv; }

__device__ __forceinline__ void transpose_item(const float* W, int N, bf16* WT, int ldk, int k0, int nsrc, int ndst, int nvalid, LAS float* scr, int lane) {
    const int n_ = lane & 31;
#pragma unroll 8
    for (int i = 0; i < 32; ++i) { const int kk = 2 * i + (lane >> 5); scr[kk * 33 + n_] = (n_ < nvalid) ? W[(size_t)(k0 + kk) * N + nsrc + n_] : 0.f; }
    LDS_WAIT(); asm volatile("" ::: "memory");
    const int c = lane & 7;
#pragma unroll
    for (int j = 0; j < 4; ++j) { const int n = (lane >> 3) + 8 * j; const LAS float* s = scr + (8 * c) * 33 + n;
        u32x4 o; o.x = pk2(s[0 * 33], s[1 * 33]); o.y = pk2(s[2 * 33], s[3 * 33]); o.z = pk2(s[4 * 33], s[5 * 33]); o.w = pk2(s[6 * 33], s[7 * 33]);
        *(u32x4*)(WT + (size_t)(ndst + n) * ldk + k0 + 8 * c) = o; }
    LDS_WAIT(); asm volatile("" ::: "memory");
}
__device__ __forceinline__ void weights_phase(const Params& p, LAS unsigned char* lds, int wv) {
    const int tid = opaque_tid(wv), lane = tid & 63, wave = wv, gw = opaque_bid() * NWAVES + wave, NGW = gridDim.x * NWAVES;
    LAS float* scr = (LAS float*)(lds + wave * 16384);
    constexpr int I_IN = 16 * 96, I_OUT = 16 * 32, I_Q = 16 * 8, I_KV = 16 * 16, I_O = 4 * 32, I_G = 16 * 88, I_D = 44 * 32;
    constexpr int I_C = 32 * 4;
    constexpr int PER_LAYER = I_IN + I_OUT + I_Q + I_KV + I_O + 2 * I_G + I_D + 2 * I_C;
    for (int it = gw; it < DEPTH * PER_LAYER; it += NGW) {
        const int l = it / PER_LAYER; int r = it % PER_LAYER;
        unsigned char* wl = p.ws + WS_W + (size_t)l * W_LAYER;
        if (r < I_IN) { const int kb = r / 96, db = r % 96, ndst = 32 * db; int nsrc, nv;
            if (ndst < 1280) { nsrc = ndst; nv = 32; } else if (ndst < 2816) { nsrc = ndst + 24; nv = 32; } else if (ndst == 2816) { nsrc = 1280; nv = 24; } else { nsrc = 0; nv = 0; }
            transpose_item(p.w_in + (size_t)l * DM * IN_W, IN_W, (bf16*)(wl + WO_IN), DM, 64 * kb, nsrc, ndst, nv, scr, lane); continue; } r -= I_IN;
        if (r < I_OUT) { const int kb = r / 32, nb = r % 32; transpose_item(p.w_out + (size_t)l * DM * DM, DM, (bf16*)(wl + WO_OUT), DM, 64 * kb, 32 * nb, 32 * nb, 32, scr, lane); continue; } r -= I_OUT;
        if (r < I_Q) { const int kb = r / 8, nb = r % 8; transpose_item(p.mem_wq + (size_t)l * DM * 256, 256, (bf16*)(wl + WO_Q), DM, 64 * kb, 32 * nb, 32 * nb, 32, scr, lane); continue; } r -= I_Q;
        if (r < I_KV) { const int kb = r / 16, nb = r % 16; transpose_item(p.mem_wkv + (size_t)l * DM * 512, 512, (bf16*)(wl + WO_KV), DM, 64 * kb, 32 * nb, 32 * nb, 32, scr, lane); continue; } r -= I_KV;
        if (r < I_O) { const int kb = r / 32, nb = r % 32; transpose_item(p.mem_wo + (size_t)l * 256 * DM, DM, (bf16*)(wl + WO_O), 256, 64 * kb, 32 * nb, 32 * nb, 32, scr, lane); continue; } r -= I_O;
        if (r < I_G) { const int kb = r / 88, nb = r % 88; transpose_item(p.ffn_wg + (size_t)l * DM * FFN, FFN, (bf16*)(wl + WO_GU), DM, 64 * kb, 32 * nb, 256 * (nb >> 2) + 32 * (nb & 3), 32, scr, lane); continue; } r -= I_G;
        if (r < I_G) { const int kb = r / 88, nb = r % 88; transpose_item(p.ffn_wu + (size_t)l * DM * FFN, FFN, (bf16*)(wl + WO_GU), DM, 64 * kb, 32 * nb, 256 * (nb >> 2) + 128 + 32 * (nb & 3), 32, scr, lane); continue; } r -= I_G;
        if (r < I_D) { const int kb = r / 32, nb = r % 32; transpose_item(p.ffn_wd + (size_t)l * FFN * DM, DM, (bf16*)(wl + WO_D), FFN, 64 * kb, 32 * nb, 32 * nb, 32, scr, lane); continue; } r -= I_D;
        if (r < I_C) { const int kb = r / 4, nb = r % 4; transpose_item(p.ck1 + (size_t)l * 2048 * 128, 128, (bf16*)(wl + WO_C1), 2048, 64 * kb, 32 * nb, 32 * nb, 32, scr, lane); continue; } r -= I_C;
        { const int kb = r / 4, nb = r % 4; transpose_item(p.cv1 + (size_t)l * 2048 * 128, 128, (bf16*)(wl + WO_C1), 2048, 64 * kb, 32 * nb, 128 + 32 * nb, 32, scr, lane); }
    }
    for (int it = gw; it < DEPTH * 2 * 128; it += NGW) { const int l = it >> 8, kv = (it >> 7) & 1, j = it & 127;
        const float* w1 = (kv ? p.cv1 : p.ck1) + (size_t)l * 2048 * 128 + j; const float* pe = p.cmp_pe + (size_t)l * 2048; float a = 0.f;
        for (int k = lane; k < 2048; k += 64) a += pe[k] * w1[(size_t)k * 128];
        a = wave_sum(a); if (lane == 0) ((float*)(p.ws + WS_CBIAS))[it] = a; }
}

template <bool RES, bool XBOUT>
__device__ __forceinline__ void row_pass(const float* xi, const bf16* h, const float* gpost, float* xo, const float* gpre, bf16* xb, int nrows, int wv) {
    const int tid = opaque_tid(wv), lane = tid & 63, wave = wv, gw = opaque_bid() * NWAVES + wave, NGW = gridDim.x * NWAVES;
    for (int m = gw; m < nrows; m += NGW) {
        const f32x4* xr = (const f32x4*)(xi + (size_t)m * DM) + lane;
        f32x4 v[4];
#pragma unroll
        for (int j = 0; j < 4; ++j) v[j] = xr[64 * j];
        if (RES) {
            const unsigned long long* hr = (const unsigned long long*)(h + (size_t)m * DM) + lane; f32x4 hv[4]; float s = 0.f;
#pragma unroll
            for (int j = 0; j < 4; ++j) { const unsigned long long hw = hr[64 * j]; const unsigned lo = (unsigned)hw, hi2 = (unsigned)(hw >> 32); hv[j] = (f32x4){bflo(lo), bfhi(lo), bflo(hi2), bfhi(hi2)};
                s += (hv[j].x * hv[j].x + hv[j].y * hv[j].y) + (hv[j].z * hv[j].z + hv[j].w * hv[j].w); }
            const float r1 = rsqrtf(wave_sum(s) * (1.f / DM) + RMS_EPS);
            f32x4* xw = (f32x4*)(xo + (size_t)m * DM) + lane;
#pragma unroll
            for (int j = 0; j < 4; ++j) { const f32x4 g = ((const f32x4*)gpost)[lane + 64 * j]; v[j] = v[j] + hv[j] * r1 * g; xw[64 * j] = v[j]; }
        }
        if (XBOUT) {
            float s2 = 0.f;
#pragma unroll
            for (int j = 0; j < 4; ++j) s2 += (v[j].x * v[j].x + v[j].y * v[j].y) + (v[j].z * v[j].z + v[j].w * v[j].w);
            const float r2 = rsqrtf(wave_sum(s2) * (1.f / DM) + RMS_EPS);
            unsigned long long* o8 = (unsigned long long*)(xb + (size_t)m * DM) + lane;
#pragma unroll
            for (int j = 0; j < 4; ++j) { const f32x4 g = ((const f32x4*)gpre)[lane + 64 * j]; const f32x4 y = v[j] * r2 * g;
                o8[64 * j] = (unsigned long long)pk2(y.x, y.y) | ((unsigned long long)pk2(y.z, y.w) << 32); }
        }
    }
}

__device__ __forceinline__ void conv_part(const Params& p, int ly, int b, int ch, const bf16* proj, bf16* xb, int lane, int wave) {
    {
        const float* cw = p.conv_w + (size_t)ly * 3 * 512 + lane * 8; const float* gn = p.gn_conv + (size_t)ly * 512 + lane * 8;
        for (int tq = wave; tq < 64; tq += NWAVES) {
            const int t = 64 * ch + tq; const size_t row = (size_t)b * SEQ + t;
            float y[8];
#pragma unroll
            for (int e = 0; e < 8; ++e) y[e] = 0.f;
#pragma unroll
            for (int k = 0; k < 3; ++k) if (t - k >= 0) {
                const u32x4 cc = *(const u32x4*)(proj + (row - k) * PROJ_LD + CCC + lane * 8), cx = *(const u32x4*)(proj + (row - k) * PROJ_LD + CCX + lane * 8);
                const float* w = cw + k * 512;
                y[0] += w[0] * bflo(cc.x) * bflo(cx.x); y[1] += w[1] * bfhi(cc.x) * bfhi(cx.x); y[2] += w[2] * bflo(cc.y) * bflo(cx.y); y[3] += w[3] * bfhi(cc.y) * bfhi(cx.y);
                y[4] += w[4] * bflo(cc.z) * bflo(cx.z); y[5] += w[5] * bfhi(cc.z) * bfhi(cx.z); y[6] += w[6] * bflo(cc.w) * bflo(cx.w); y[7] += w[7] * bfhi(cc.w) * bfhi(cx.w); }
            const u32x4 cb = *(const u32x4*)(proj + row * PROJ_LD + CCB + lane * 8);
            y[0] *= bflo(cb.x); y[1] *= bfhi(cb.x); y[2] *= bflo(cb.y); y[3] *= bfhi(cb.y); y[4] *= bflo(cb.z); y[5] *= bfhi(cb.z); y[6] *= bflo(cb.w); y[7] *= bfhi(cb.w);
            float ss = 0.f;
#pragma unroll
            for (int e = 0; e < 8; ++e) ss += y[e] * y[e];
            const float r = rsqrtf(wave_sum(ss) * (1.f / 512.f) + RMS_EPS);
            u32x4 w; w.x = pk2(y[0] * r * gn[0], y[1] * r * gn[1]); w.y = pk2(y[2] * r * gn[2], y[3] * r * gn[3]); w.z = pk2(y[4] * r * gn[4], y[5] * r * gn[5]); w.w = pk2(y[6] * r * gn[6], y[7] * r * gn[7]);
            *(u32x4*)(xb + row * DM + 512 + lane * 8) = w;
        }
    }
}


namespace nsa {
typedef short bf16x8 __attribute__((ext_vector_type(8)));
typedef float f32x16 __attribute__((ext_vector_type(16)));
typedef short s16x4 __attribute__((ext_vector_type(4)));
constexpr int KROWB = 144, KT_BYTES = 64 * KROWB, VT_BYTES = 8192;
constexpr int L_K = 0, L_V = 2 * KT_BYTES, L_TB = L_V + 2 * VT_BYTES, L_TBC = L_TB + 8 * 384 * 4, L_IMPA = L_TBC + 8 * 132 * 4, L_IMPB = L_IMPA + 8192, L_SELM = L_IMPB + 8192, L_END = L_SELM + 256;
constexpr float LOG2E = 1.4426950408889634f, QSCALE = 0.125f * LOG2E, NEG = -2e30f, MINIT = -1e30f;

__device__ __forceinline__ void build_tables(const float* rel_bias, LAS unsigned char* lds, int tid) {
    LAS float* TB = (LAS float*)(lds + L_TB); LAS float* TBC = (LAS float*)(lds + L_TBC);
    for (int e = tid; e < 8 * 384; e += NTHREADS) { const int h = e / 384, x = e % 384, dist = 319 - x; TB[e] = (dist < 0 || dist > 255) ? NEG : rel_bias[h * 32 + T5_BUCKET[dist > 127 ? 127 : dist]] * LOG2E; }
    for (int e = tid; e < 8 * 132; e += NTHREADS) { const int h = e / 132, idx = e % 132; TBC[e] = (idx == 0 || idx > 128) ? NEG : rel_bias[h * 32 + T5_BUCKET[idx - 1]] * LOG2E; }
    __syncthreads();
}
__device__ __forceinline__ float quad_sum(float x) { x += xor1f(x); x += xor2f(x); return x; }
__device__ __forceinline__ unsigned cvtpk(float lo, float hi) { unsigned r; asm volatile("v_cvt_pk_bf16_f32 %0, %1, %2" : "=v"(r) : "v"(lo), "v"(hi)); return r; }
__device__ __forceinline__ s16x4 tr_read(LAS const unsigned char* p) { typedef short v4i16_t __attribute__((ext_vector_type(4))); return __builtin_bit_cast(s16x4, __builtin_amdgcn_ds_read_tr16_b64_v4i16((LAS v4i16_t*)p)); }

struct TileSrc { const bf16* K; const bf16* V; int stride; };
__device__ __forceinline__ void qk_tile(f32x16& p0, f32x16& p1, LAS const unsigned char* kt, const bf16x8 (&qf)[4], int r32, int hi) {
    LAS const unsigned char* kb = kt + r32 * KROWB + hi * 16;
#pragma unroll
    for (int d0 = 0; d0 < 4; ++d0) {
        const bf16x8 a0 = *(LAS const bf16x8*)(kb + d0 * 32), a1 = *(LAS const bf16x8*)(kb + 32 * KROWB + d0 * 32);
        p0 = __builtin_amdgcn_mfma_f32_32x32x16_bf16(a0, qf[d0], p0, 0, 0, 0); p1 = __builtin_amdgcn_mfma_f32_32x32x16_bf16(a1, qf[d0], p1, 0, 0, 0); }
}
__device__ __forceinline__ void pv_tile(f32x16 (&o)[2], LAS const unsigned char* vt, const u32x4 (&pw)[4], int lane) {
    const int hi = lane >> 5, grp = (lane >> 4) & 1, i = lane & 15;
    LAS const unsigned char* vb = vt + (4 * hi + (i >> 2)) * 64 + (16 * grp + 4 * (i & 3)) * 2;
#pragma unroll
    for (int dblk = 0; dblk < 2; ++dblk)
#pragma unroll
        for (int s = 0; s < 4; ++s) {
            const s16x4 lo = tr_read(vb + dblk * 4096 + (16 * s) * 64), hi4 = tr_read(vb + dblk * 4096 + (16 * s + 8) * 64);
            const bf16x8 vf = (bf16x8){lo[0], lo[1], lo[2], lo[3], hi4[0], hi4[1], hi4[2], hi4[3]};
            o[dblk] = __builtin_amdgcn_mfma_f32_32x32x16_bf16(vf, __builtin_bit_cast(bf16x8, pw[s]), o[dblk], 0, 0, 0); }
}
__device__ __forceinline__ float vmax16(const f32x16& a, const f32x16& b) {
    float x = fmaxf(a[0], b[0]);
#pragma unroll
    for (int r = 1; r < 16; ++r) x = fmaxf(x, fmaxf(a[r], b[r]));
    return x;
}
__device__ __forceinline__ void pack_p(u32x4 (&pw)[4], const f32x16& p0, const f32x16& p1) {
    pw[0] = (u32x4){cvtpk(p0[0], p0[1]), cvtpk(p0[2], p0[3]), cvtpk(p0[4], p0[5]), cvtpk(p0[6], p0[7])};
    pw[1] = (u32x4){cvtpk(p0[8], p0[9]), cvtpk(p0[10], p0[11]), cvtpk(p0[12], p0[13]), cvtpk(p0[14], p0[15])};
    pw[2] = (u32x4){cvtpk(p1[0], p1[1]), cvtpk(p1[2], p1[3]), cvtpk(p1[4], p1[5]), cvtpk(p1[6], p1[7])};
    pw[3] = (u32x4){cvtpk(p1[8], p1[9]), cvtpk(p1[10], p1[11]), cvtpk(p1[12], p1[13]), cvtpk(p1[14], p1[15])};
}
template <bool LOOKUP>
__device__ __forceinline__ void soft_tile(f32x16& p0, f32x16& p1, LAS const float* tbp, float& m, float& l, f32x16 (&o)[2], u32x4 (&pw)[4]) {
    if (LOOKUP) {
#pragma unroll
        for (int r = 0; r < 16; ++r) { p0[r] += tbp[(r & 3) + 8 * (r >> 2)]; p1[r] += tbp[32 + (r & 3) + 8 * (r >> 2)]; }
    }
    float mx = vmax16(p0, p1); mx = half_max(mx);
    const float mn = fmaxf(m, mx), alpha = __builtin_amdgcn_exp2f(m - mn); m = mn;
    float rs = 0.f;
#pragma unroll
    for (int r = 0; r < 16; ++r) { p0[r] = __builtin_amdgcn_exp2f(p0[r] - mn); p1[r] = __builtin_amdgcn_exp2f(p1[r] - mn); rs += p0[r] + p1[r]; }
    l = l * alpha + rs;
#pragma unroll
    for (int r = 0; r < 16; ++r) { o[0][r] *= alpha; o[1][r] *= alpha; }
    pack_p(pw, p0, p1);
}

__device__ __forceinline__ void nsa_unit(const Params& p, int b, int c, int g, LAS unsigned char* lds, int wv) {
    const int tid = opaque_tid(wv);
    const int lane = tid & 63, w = wv, r32 = lane & 31, hi = lane >> 5, qi = r32 >> 2, hh = r32 & 3, h = 4 * g + hh, ql = 8 * w + qi, t = 64 * c + ql;
    const size_t row = (size_t)b * SEQ + t;
    const bf16* proj = (const bf16*)(p.ws + WS_PROJ);
    const bf16* kcb = (const bf16*)(p.ws + WS_KCMP) + (size_t)(b * 2 + g) * 128 * 64; const bf16* vcb = (const bf16*)(p.ws + WS_VCMP) + (size_t)(b * 2 + g) * 128 * 64;
    const int skey = tid >> 3, sch = tid & 7;
    LAS unsigned char* kdst = lds + L_K + skey * KROWB + sch * 16; LAS unsigned char* vdst = lds + L_V + (sch >> 2) * 4096 + skey * 64 + (sch & 3) * 16;
    const int NT = 2 + (c + 1) + (c + 1 < 5 ? c + 1 : 5), w0 = c > 4 ? c - 4 : 0;
#define NSA_SRC(i, S_) do { if ((i) < 2) { S_.K = kcb + (size_t)(64 * (i)) * 64; S_.V = vcb + (size_t)(64 * (i)) * 64; S_.stride = 64; } \
        else if ((i) < 3 + c) { S_.K = proj + ((size_t)b * SEQ + 64 * ((i) - 2)) * PROJ_LD + CKS + 64 * g; S_.V = S_.K + (CVS - CKS); S_.stride = PROJ_LD; } \
        else { S_.K = proj + ((size_t)b * SEQ + 64 * (w0 + (i) - 3 - c)) * PROJ_LD + CKW + 64 * g; S_.V = S_.K + (CVW - CKW); S_.stride = PROJ_LD; } } while (0)
#define NSA_LOAD(i) do { TileSrc s_; NSA_SRC(i, s_); kreg = *(const u32x4*)(s_.K + (size_t)skey * s_.stride + sch * 8); vreg = *(const u32x4*)(s_.V + (size_t)skey * s_.stride + sch * 8); } while (0)
#define NSA_WRITE(buf) do { *(LAS u32x4*)(kdst + (buf) * KT_BYTES) = kreg; *(LAS u32x4*)(vdst + (buf) * VT_BYTES) = vreg; } while (0)
    u32x4 kreg, vreg;
    NSA_LOAD(0);
    bf16x8 qf[4];
#pragma unroll
    for (int d0 = 0; d0 < 4; ++d0) qf[d0] = *(const bf16x8*)(proj + row * PROJ_LD + CQ + h * 64 + 16 * d0 + 8 * hi);
    const bf16* gl = proj + row * PROJ_LD + CGL + h * 3;
    const float g0 = 1.f / (1.f + __expf(-__uint_as_float((unsigned)gl[0] << 16))), g1 = 1.f / (1.f + __expf(-__uint_as_float((unsigned)gl[1] << 16))), g2 = 1.f / (1.f + __expf(-__uint_as_float((unsigned)gl[2] << 16)));
    NSA_WRITE(0);
    __syncthreads();
    f32x16 o[2], out[2]; u32x4 pw[4];
    LAS const float* TBh = (LAS const float*)(lds + L_TB) + h * 384; LAS const float* TBCh = (LAS const float*)(lds + L_TBC) + h * 132;
    const float rb31 = TBCh[128];
    unsigned selm;
    {
        f32x16 pa0, pa1, pb0, pb1;
#pragma unroll
        for (int r = 0; r < 16; ++r) { pa0[r] = 0.f; pa1[r] = 0.f; pb0[r] = 0.f; pb1[r] = 0.f; }
        NSA_LOAD(1);
        qk_tile(pa0, pa1, lds + L_K, qf, r32, hi);
        NSA_WRITE(1);
        __syncthreads();
        NSA_LOAD(2);
        qk_tile(pb0, pb1, lds + L_K + KT_BYTES, qf, r32, hi);
        const int Dc = t - 31 - 64 * hi; int hib = 127; asm volatile("" : "+s"(hib));
#pragma unroll
        for (int r = 0; r < 16; ++r) { const int nr = (r & 3) + 8 * (r >> 2);
            { const int d = Dc - 16 * nr; pa0[r] += TBCh[min(max(d, -1), hib) + 1]; }
            { const int d = Dc - 16 * (32 + nr); pa1[r] += TBCh[min(max(d, -1), hib) + 1]; }
            { const int d = Dc - 16 * (64 + nr); pb0[r] += TBCh[min(max(d, -1), hib) + 1]; }
            { const int d = Dc - 16 * (96 + nr); pb1[r] += TBCh[min(max(d, -1), hib) + 1]; } }
        float mx = fmaxf(vmax16(pa0, pa1), vmax16(pb0, pb1)); mx = half_max(mx); mx = fmaxf(mx, MINIT);
        float rs = 0.f;
#pragma unroll
        for (int r = 0; r < 16; ++r) { pa0[r] = __builtin_amdgcn_exp2f(pa0[r] - mx); pa1[r] = __builtin_amdgcn_exp2f(pa1[r] - mx); pb0[r] = __builtin_amdgcn_exp2f(pb0[r] - mx); pb1[r] = __builtin_amdgcn_exp2f(pb1[r] - mx);
            rs += (pa0[r] + pa1[r]) + (pb0[r] + pb1[r]); }
        rs = half_sum(rs);
        const float il = rs > 0.f ? 1.f / rs : 0.f;
#pragma unroll
        for (int r = 0; r < 16; ++r) { pa0[r] *= il; pa1[r] *= il; pb0[r] *= il; pb1[r] *= il; }
        LAS float* IA = (LAS float*)(lds + L_IMPA) + w * 256 + qi * 32; LAS float* IB = (LAS float*)(lds + L_IMPB) + w * 256 + qi * 32;
#pragma unroll
        for (int k = 0; k < 4; ++k) {
            const float a0 = quad_sum((pa0[4 * k] + pa0[4 * k + 1]) + (pa0[4 * k + 2] + 0.5f * pa0[4 * k + 3])), b0 = quad_sum(0.5f * pa0[4 * k + 3]);
            const float a1 = quad_sum((pa1[4 * k] + pa1[4 * k + 1]) + (pa1[4 * k + 2] + 0.5f * pa1[4 * k + 3])), b1 = quad_sum(0.5f * pa1[4 * k + 3]);
            const float a2 = quad_sum((pb0[4 * k] + pb0[4 * k + 1]) + (pb0[4 * k + 2] + 0.5f * pb0[4 * k + 3])), b2 = quad_sum(0.5f * pb0[4 * k + 3]);
            const float a3 = quad_sum((pb1[4 * k] + pb1[4 * k + 1]) + (pb1[4 * k + 2] + 0.5f * pb1[4 * k + 3])), b3 = quad_sum(0.5f * pb1[4 * k + 3]);
            if (hh == 0) { const int j = 2 * k + hi; IA[j] = a0; IB[j] = b0; IA[8 + j] = a1; IB[8 + j] = b1; IA[16 + j] = a2; IB[16 + j] = b2; IA[24 + j] = a3; IB[24 + j] = b3; } }
        asm volatile("s_waitcnt lgkmcnt(0)" ::: "memory");
        if (lane < 8) { unsigned mask;
            if (c < 8) mask = (1u << (c + 1)) - 1u;
            else { mask = 1u | (1u << c) | (1u << (c - 1));
                LAS const float* A = (LAS const float*)(lds + L_IMPA) + w * 256 + lane * 32; LAS const float* B = (LAS const float*)(lds + L_IMPB) + w * 256 + lane * 32;
                for (int rr = 0; rr < 5; ++rr) { int best = 1; float bv = -1.f;
                    for (int j = 1; j <= c - 2; ++j) { const float v = A[j] + B[j - 1]; if (!((mask >> j) & 1u) && v > bv) { bv = v; best = j; } }
                    mask |= 1u << best; } }
            ((LAS unsigned*)(lds + L_SELM))[w * 8 + lane] = mask; }
        asm volatile("s_waitcnt lgkmcnt(0)" ::: "memory");
        selm = ((LAS const unsigned*)(lds + L_SELM))[w * 8 + qi];
#pragma unroll
        for (int r = 0; r < 16; ++r) { o[0][r] = 0.f; o[1][r] = 0.f; }
        pack_p(pw, pa0, pa1); pv_tile(o, lds + L_V, pw, lane);
        pack_p(pw, pb0, pb1); pv_tile(o, lds + L_V + VT_BYTES, pw, lane);
#pragma unroll
        for (int r = 0; r < 16; ++r) { out[0][r] = g0 * o[0][r]; out[1][r] = g0 * o[1][r]; o[0][r] = 0.f; o[1][r] = 0.f; }
        __syncthreads();
        NSA_WRITE(0);
        __syncthreads();
    }
    float m = MINIT, l = 0.f;
    for (int i = 2; i < NT; ++i) {
        const bool more = i + 1 < NT;
        if (more) NSA_LOAD(i + 1);
        const bool win = i >= 3 + c; const int j = win ? w0 + i - 3 - c : i - 2, dj = c - j;
        const bool lookup = dj <= 2 || (win && dj == 4);
        const bool on = win || ((selm >> j) & 1u);
        const float cb = lookup ? (on ? 0.f : NEG) : (on ? rb31 : NEG);
        f32x16 p0, p1;
#pragma unroll
        for (int r = 0; r < 16; ++r) { p0[r] = cb; p1[r] = cb; }
        LAS const unsigned char* kt = lds + L_K + (i & 1) * KT_BYTES; LAS const unsigned char* vt = lds + L_V + (i & 1) * VT_BYTES;
        qk_tile(p0, p1, kt, qf, r32, hi);
        if (lookup) soft_tile<true>(p0, p1, TBh + (319 - (64 * dj + ql) + 4 * hi), m, l, o, pw);
        else soft_tile<false>(p0, p1, TBh, m, l, o, pw);
        pv_tile(o, vt, pw, lane);
        if (i == 2 + c || i == NT - 1) {
            const float lt = half_sum(l), wgt = (win ? g2 : g1) / lt;
#pragma unroll
            for (int r = 0; r < 16; ++r) { out[0][r] += wgt * o[0][r]; out[1][r] += wgt * o[1][r]; o[0][r] = 0.f; o[1][r] = 0.f; }
            m = MINIT; l = 0.f; }
        if (more) NSA_WRITE((i + 1) & 1);
        __syncthreads();
    }
    float* outp = (float*)(p.ws + WS_H) + row * DM + h * 64 + 4 * hi;
#pragma unroll
    for (int dblk = 0; dblk < 2; ++dblk)
#pragma unroll
        for (int k = 0; k < 4; ++k) *(f32x4*)(outp + 32 * dblk + 8 * k) = (f32x4){out[dblk][4 * k], out[dblk][4 * k + 1], out[dblk][4 * k + 2], out[dblk][4 * k + 3]};
#undef NSA_SRC
#undef NSA_LOAD
#undef NSA_WRITE
}
}

__device__ __forceinline__ void nsa_item_mfma(const Params& p, int ly, int item, LAS unsigned char* lds, int wv) {
    const int tid = opaque_tid(wv);
    const int b = item >> 5, ch = item & 31, lane = tid & 63, wave = wv;
    const bf16* proj = (const bf16*)(p.ws + WS_PROJ);
    bf16* xb = (bf16*)(p.ws + WS_XB);
    conv_part(p, ly, b, ch, proj, xb, lane, wave);
    nsa::nsa_unit(p, b, ch, 0, lds, wv);
    nsa::nsa_unit(p, b, ch, 1, lds, wv);
    __syncthreads();
    { const int ql = tid >> 3, h = tid & 7; const size_t row = (size_t)b * SEQ + 64 * ch + ql;
      const f32x4* src = (const f32x4*)((const float*)(p.ws + WS_H) + row * DM + h * 64); f32x4 v[16]; float ss = 0.f;
#pragma unroll
      for (int c = 0; c < 16; ++c) { v[c] = src[c]; ss += (v[c].x * v[c].x + v[c].y * v[c].y) + (v[c].z * v[c].z + v[c].w * v[c].w); }
      ss += xor1f(ss); ss += xor2f(ss); ss += xor4f(ss);
      const float r = rsqrtf(ss * (1.f / 512.f) + RMS_EPS); const f32x4* gn = (const f32x4*)(p.gn_nsa + (size_t)ly * 512 + h * 64);
      u32x4* dst = (u32x4*)(xb + row * DM + h * 64);
#pragma unroll
      for (int c = 0; c < 8; ++c) { const f32x4 a = v[2 * c] * r * gn[2 * c], bb = v[2 * c + 1] * r * gn[2 * c + 1]; u32x4 wv; wv.x = pk2(a.x, a.y); wv.y = pk2(a.z, a.w); wv.z = pk2(bb.x, bb.y); wv.w = pk2(bb.z, bb.w); dst[c] = wv; } }
    __syncthreads();
}

__device__ __forceinline__ void memattn_unit(const Params& p, int ly, int unit, LAS unsigned char* lds, int wv) {
    using namespace nsa;
    const int tid = opaque_tid(wv), lane = tid & 63, w = wv, r32 = lane & 31, hi = lane >> 5;
    const int b = unit >> 5, hm = (unit >> 3) & 3, qb = unit & 7;
    const bf16* kv = (const bf16*)(p.ws + WS_MEMKV) + (size_t)ly * 4096 * 512 + (size_t)b * MEML * 512 + hm * 64;
    constexpr int MK = 0, MV = 4 * KT_BYTES;
    { const int skey = tid >> 3, sch = tid & 7;
      u32x4 kr[4], vr[4];
#pragma unroll
      for (int tt = 0; tt < 4; ++tt) { kr[tt] = *(const u32x4*)(kv + (size_t)(64 * tt + skey) * 512 + sch * 8); vr[tt] = *(const u32x4*)(kv + (size_t)(64 * tt + skey) * 512 + 256 + sch * 8); }
#pragma unroll
      for (int tt = 0; tt < 4; ++tt) { *(LAS u32x4*)(lds + MK + tt * KT_BYTES + skey * KROWB + sch * 16) = kr[tt]; *(LAS u32x4*)(lds + MV + tt * VT_BYTES + (sch >> 2) * 4096 + skey * 64 + (sch & 3) * 16) = vr[tt]; } }
    const size_t row = (size_t)b * SEQ + 256 * qb + 32 * w + r32;
    bf16x8 qf[4];
#pragma unroll
    for (int d0 = 0; d0 < 4; ++d0) qf[d0] = *(const bf16x8*)((const bf16*)(p.ws + WS_QM) + row * 256 + hm * 64 + 16 * d0 + 8 * hi);
    __syncthreads();
    f32x16 o[2]; u32x4 pw[4]; float m = MINIT, l = 0.f;
#pragma unroll
    for (int r = 0; r < 16; ++r) { o[0][r] = 0.f; o[1][r] = 0.f; }
    for (int tt = 0; tt < 4; ++tt) {
        f32x16 p0, p1;
#pragma unroll
        for (int r = 0; r < 16; ++r) { p0[r] = 0.f; p1[r] = 0.f; }
        qk_tile(p0, p1, lds + MK + tt * KT_BYTES, qf, r32, hi);
        soft_tile<false>(p0, p1, (LAS const float*)lds, m, l, o, pw);
        pv_tile(o, lds + MV + tt * VT_BYTES, pw, lane);
    }
    const float il = 1.f / half_sum(l);
    bf16* dst = (bf16*)(p.ws + WS_OM) + row * 256 + hm * 64 + 4 * hi;
#pragma unroll
    for (int dblk = 0; dblk < 2; ++dblk)
#pragma unroll
        for (int k = 0; k < 4; ++k) { const unsigned long long v = (unsigned long long)pk2(o[dblk][4 * k] * il, o[dblk][4 * k + 1] * il) | ((unsigned long long)pk2(o[dblk][4 * k + 2] * il, o[dblk][4 * k + 3] * il) << 32);
            *(unsigned long long*)(dst + 32 * dblk + 8 * k) = v; }
    __syncthreads();
}

#define XB_TMO      128
#define XB_XCNT(j)  (256  + 64 * (j))
#define XB_XSUB(j)  (1280 + 64 * (j))
#define XB_XGEN(j)  (2304 + 64 * (j))
#define XB_TOP      3328
#define XB_TOPGEN   3392
#define XCD_BAR_WORDS 3456
#define XB_SPIN_CAP (1u << 18)

__device__ __forceinline__ unsigned xb_ld(unsigned* p)              { return __hip_atomic_load(p, __ATOMIC_RELAXED, __HIP_MEMORY_SCOPE_AGENT); }
__device__ __forceinline__ unsigned xb_add(unsigned* p, unsigned v) { return __hip_atomic_fetch_add(p, v, __ATOMIC_RELAXED, __HIP_MEMORY_SCOPE_AGENT); }
__device__ __forceinline__ unsigned xb_xcc_id() { return (unsigned)__builtin_amdgcn_s_getreg((3 << 11) | 20) & 0xFu; }
#define XB_SPIN(cond, bar) do { unsigned _sp = 0; while (cond) { __builtin_amdgcn_s_sleep(1); \
    if ((++_sp & 255u) == 0u) { if (xb_ld(&(bar)[XB_TMO])) break; if (_sp > XB_SPIN_CAP) { atomicAdd(&(bar)[XB_TMO], 1u); break; } } } } while (0)

struct XcdBarrier {
    unsigned* bar; unsigned x;
    volatile LAS unsigned* st;
};

__device__ __forceinline__ XcdBarrier xcd_barrier_post(unsigned* bar, volatile LAS unsigned* st, int wv) {
    XcdBarrier b; b.bar = bar; b.x = xb_xcc_id(); b.st = st;
    if (opaque_tid(wv) == 0) (void)xb_add(&bar[XB_XCNT(b.x)], 1u);
    return b;
}
__device__ __forceinline__ void xcd_barrier_complete(unsigned* bar, unsigned x, unsigned& nloc, unsigned& nx) {
    const unsigned G = gridDim.x * gridDim.y * gridDim.z;
    unsigned sum, cnt, mine, sp = 0u;
    for (;;) {
        sum = 0u; cnt = 0u; mine = 0u;
#pragma unroll
        for (unsigned j = 0; j < 16; ++j) { const unsigned c = xb_ld(&bar[XB_XCNT(j)]); sum += c; cnt += (c > 0u) ? 1u : 0u; mine = (j == x) ? c : mine; }
        if (sum == G) break;
        __builtin_amdgcn_s_sleep(1);
        if ((++sp & 255u) == 0u) { if (xb_ld(&bar[XB_TMO])) break; if (sp > XB_SPIN_CAP) { atomicAdd(&bar[XB_TMO], 1u); break; } }
    }
    nloc = mine > 0u ? mine : 1u; nx = cnt > 0u ? cnt : 1u;
}

__device__ __forceinline__ void xcd_barrier(const XcdBarrier& b, int wv) {
    asm volatile("s_waitcnt vmcnt(0)" ::: "memory");
    __syncthreads();
    if (opaque_tid(wv) == 0) {
        unsigned* bar = b.bar; asm volatile("" : "+s"(bar));
        __builtin_amdgcn_s_waitcnt(0);
        unsigned nloc = b.st[0], nx = b.st[1];
        if (nloc == 0u) { xcd_barrier_complete(bar, b.x, nloc, nx); b.st[0] = nloc; b.st[1] = nx; }
        const unsigned old = xb_add(&bar[XB_XSUB(b.x)], 1u);
        const unsigned gen = old / nloc;
        if (old + 1u == (gen + 1u) * nloc) {
            __builtin_amdgcn_fence(__ATOMIC_RELEASE, "agent");
            asm volatile("s_waitcnt vmcnt(0)" ::: "memory");
            const unsigned og = xb_add(&bar[XB_TOP], 1u);
            const unsigned tg = og / nx;
            if (og + 1u == (tg + 1u) * nx) xb_add(&bar[XB_TOPGEN], 1u);
            else XB_SPIN(xb_ld(&bar[XB_TOPGEN]) == tg, bar);
            __builtin_amdgcn_fence(__ATOMIC_ACQUIRE, "agent");
            xb_add(&bar[XB_XGEN(b.x)], 1u);
            asm volatile("s_waitcnt vmcnt(0)" ::: "memory");
        } else {
            XB_SPIN(xb_ld(&bar[XB_XGEN(b.x)]) == gen, bar);
            __builtin_amdgcn_fence(__ATOMIC_ACQUIRE, "agent");
            asm volatile("s_waitcnt vmcnt(0)" ::: "memory");
        }
    }
    __syncthreads();
}

template <class Epi>
__device__ __forceinline__ void run_gemm(LAS unsigned char* lds, int bid, const bf16* A, const bf16* Bt, int M, int N, int K, const Epi& E, int wv, int lda = 0, int blk_shift = 0) {
    pg8::Gemm g{A, Bt, M, N, K, lda ? lda : K}; pg8::StaticOrder S; S.init(M, N, (int)gridDim.x, (int)((unsigned)(bid + blk_shift) % gridDim.x));
    pg8::gemm_phase<Epi, pg8::StaticOrder, !Epi::AFTER_DRAIN, true>(lds, g, S, E, wv);
}

__global__ void __launch_bounds__(NTHREADS, 2) hymba_fwd(Params p) {
    extern __shared__ __attribute__((aligned(16))) unsigned char lds_raw[];
    LAS unsigned char* lds = (LAS unsigned char*)lds_raw;
    cg::grid_group grid = cg::this_grid();
    const int G = gridDim.x;
    const int wv = __builtin_amdgcn_readfirstlane((int)(threadIdx.x >> 6));
    unsigned char* const ws0 = p.ws;
    volatile LAS unsigned* MISC = (volatile LAS unsigned*)(lds + MISC_OFF);
    { const int t0 = opaque_tid(wv); if (t0 < 32) MISC[t0] = 0u; }
    __syncthreads();
    XcdBarrier bar = xcd_barrier_post((unsigned*)(ws0 + WS_CTL) + CW_BAR, MISC + 8, wv);
    int ph = 0, l = 0;
#define PHASE_BEGIN { unsigned char* ws = ws0; asm volatile("" : "+s"(ws)); int bid = blockIdx.x; asm volatile("" : "+s"(bid)); Params q = p; q.ws = ws; \
    bf16* XB = (bf16*)(ws + WS_XB); bf16* H = (bf16*)(ws + WS_H); bf16* PROJ = (bf16*)(ws + WS_PROJ); bf16* HID = PROJ; bf16* QM = (bf16*)(ws + WS_QM); bf16* OM = (bf16*)(ws + WS_OM); \
    bf16* MEMN = (bf16*)(ws + WS_MEMN); bf16* MEMKV = (bf16*)(ws + WS_MEMKV); const unsigned char* wl = ws + WS_W + (size_t)l * W_LAYER; const float* nl = p.norms + (size_t)l * 6 * DM; \
    (void)XB; (void)H; (void)PROJ; (void)HID; (void)QM; (void)OM; (void)MEMN; (void)MEMKV; (void)wl; (void)nl;
#define PHASE_END   if (ph == 0) grid.sync(); else if (ph + 1 < N_PHASES) xcd_barrier(bar, wv); } ++ph;

    PHASE_BEGIN
        weights_phase(q, lds, wv);
        row_pass<false, true>(p.x, nullptr, nullptr, nullptr, p.norms, XB, T, wv);
        for (int lm = 0; lm < DEPTH; ++lm) row_pass<false, true>(p.mem, nullptr, nullptr, nullptr, p.mem_norm + lm * DM, MEMN + (size_t)lm * 4096 * DM, BATCH * MEML, wv);
        __syncthreads();
    PHASE_END

    for (l = 0; l < DEPTH; ++l) {
        PHASE_BEGIN
            run_gemm(lds, bid, XB, (const bf16*)(wl + WO_IN), T, PROJ_LD, DM, pg8::EpiStoreBf16{PROJ, PROJ_LD, 2, nsa::QSCALE, (bf16*)(ws + WS_KC2), 2}, wv);
        PHASE_END
        PHASE_BEGIN
            { const float* cbl = (const float*)(ws + WS_CBIAS) + l * 256;
              run_gemm(lds, bid, (const bf16*)(ws + WS_KC2), (const bf16*)(wl + WO_C1), 4096, 256, 2048, pg8::EpiCompress<0>{cbl, p.ck2 + (size_t)l * 128 * 64, (bf16*)(ws + WS_KCMP)}, wv, 1024, 0);
              run_gemm(lds, bid, (const bf16*)(ws + WS_KC2) + (size_t)4096 * 1024, (const bf16*)(wl + WO_C1), 4096, 256, 2048, pg8::EpiCompress<1>{cbl + 128, p.cv2 + (size_t)l * 128 * 64, (bf16*)(ws + WS_VCMP)}, wv, 1024, 128);
              run_gemm(lds, bid, MEMN + (size_t)l * 4096 * DM, (const bf16*)(wl + WO_KV), BATCH * MEML, 512, DM, pg8::EpiStoreBf16{MEMKV + (size_t)l * 4096 * 512, 512, 0, 1.f, nullptr, -1}, wv, 0, 224); }
        PHASE_END
        PHASE_BEGIN
            nsa::build_tables(p.rel_bias, lds, opaque_tid(wv));
            for (int it = bid; it < BATCH * 32; it += G) nsa_item_mfma(q, l, (it & ~31) | (it < 256 ? 31 - (it & 31) : (it & 31)), lds, wv);
        PHASE_END
        PHASE_BEGIN
            run_gemm(lds, bid, XB, (const bf16*)(wl + WO_OUT), T, DM, DM, pg8::EpiStoreBf16{H, DM, 0, 1.f, nullptr, -1}, wv);
        PHASE_END
        PHASE_BEGIN
            row_pass<true, true>(l == 0 ? p.x : p.out, H, nl + DM, p.out, nl + 2 * DM, XB, T, wv);
        PHASE_END
        PHASE_BEGIN
            run_gemm(lds, bid, XB, (const bf16*)(wl + WO_Q), T, 256, DM, pg8::EpiStoreBf16{QM, 256, 1, nsa::QSCALE, nullptr, -1}, wv);
        PHASE_END
        PHASE_BEGIN
            for (int it = bid; it < BATCH * 32; it += G) memattn_unit(q, l, it, lds, wv);
        PHASE_END
        PHASE_BEGIN
            run_gemm(lds, bid, OM, (const bf16*)(wl + WO_O), T, DM, 256, pg8::EpiStoreBf16{H, DM, 0, 1.f, nullptr, -1}, wv);
        PHASE_END
        PHASE_BEGIN
            row_pass<true, true>(p.out, H, nl + 3 * DM, p.out, nl + 4 * DM, XB, T, wv);
        PHASE_END
        PHASE_BEGIN
            run_gemm(lds, bid, XB, (const bf16*)(wl + WO_GU), T, 2 * FFN, DM, pg8::EpiSwiGLU{HID, FFN}, wv);
        PHASE_END
        PHASE_BEGIN
            run_gemm(lds, bid, HID, (const bf16*)(wl + WO_D), T, DM, FFN, pg8::EpiStoreBf16{H, DM, 0, 1.f, nullptr, -1}, wv);
        PHASE_END
        PHASE_BEGIN
            if (l + 1 < DEPTH) row_pass<true, true>(p.out, H, nl + 5 * DM, p.out, nl + 6 * DM, XB, T, wv);
            else row_pass<true, false>(p.out, H, nl + 5 * DM, p.out, nullptr, nullptr, T, wv);
        PHASE_END
    }
}

extern "C" void kernel_launch(void* const* d_in, const int* in_sizes, int n_in, void* d_out, int out_size, void* d_ws, size_t ws_size, hipStream_t stream) {
    static int grid = 0;
    if (grid == 0) {
        if (n_in != 21 || in_sizes[0] != T * DM || out_size != T * DM || ws_size < WS_END) { fprintf(stderr, "kernel_launch: unexpected problem (n_in %d, in0 %d, out %d, ws %zu < %zu)\n", n_in, n_in > 0 ? in_sizes[0] : -1, out_size, ws_size, (size_t)WS_END); grid = -1; return; }
        int dev = 0, cus = 0, per_cu = 0;
        if (hipGetDevice(&dev) != hipSuccess || hipDeviceGetAttribute(&cus, hipDeviceAttributeMultiprocessorCount, dev) != hipSuccess) { grid = -1; return; }
        if (hipFuncSetAttribute((const void*)hymba_fwd, hipFuncAttributeMaxDynamicSharedMemorySize, LDS_BYTES) != hipSuccess) { fprintf(stderr, "kernel_launch: hipFuncSetAttribute failed\n"); grid = -1; return; }
        if (hipOccupancyMaxActiveBlocksPerMultiprocessor(&per_cu, (const void*)hymba_fwd, NTHREADS, LDS_BYTES) != hipSuccess || per_cu < 1) { fprintf(stderr, "kernel_launch: occupancy query says %d blocks per CU\n", per_cu); grid = -1; return; }
        grid = cus;
    }
    if (grid < 0) return;
    Params p{};
    const float** fp = (const float**)&p;
    for (int i = 0; i < 21; ++i) fp[i] = (const float*)d_in[i];
    p.out = (float*)d_out; p.ws = (unsigned char*)d_ws;
    if (hipMemsetAsync((char*)d_ws + WS_CTL, 0, CTL_ZERO_BYTES, stream) != hipSuccess) { fprintf(stderr, "kernel_launch: hipMemsetAsync failed\n"); return; }
    { void* args[] = {&p};
      hipError_t e = hipLaunchCooperativeKernel((void*)hymba_fwd, dim3(grid), dim3(NTHREADS), args, LDS_BYTES, stream);
      if (e != hipSuccess) fprintf(stderr, "cooperative launch failed: %s (grid %d)\n", hipGetErrorString(e), grid); }
}
```
